# Optimizing an MI355X kernel written in HIP

```python
import jax, jax.numpy as jnp
from jax import lax
import numpy as np

D_MODEL = 1024
BATCH = 16
SEQ = 2048
DEPTH = 1

HEAD_DIM = 64
A_HEADS = 8
A_WIDTH = A_HEADS * HEAD_DIM
CHUNK = 128
B_HEADS = 8
B_KV_HEADS = 2
B_GROUP = B_HEADS // B_KV_HEADS
B_WIDTH = B_HEADS * HEAD_DIM
KV_WIDTH = B_KV_HEADS * HEAD_DIM
D_MIX = A_WIDTH + B_WIDTH
IN_WIDTH = 2 * A_WIDTH + B_WIDTH + 2 * KV_WIDTH
Q_BLOCK = 128
GRID_W = 64
ROPE_BASE = 10000.0
N_EXPERTS = 16
CAPACITY_FACTOR = 2
EXPERT_FF = 1024
EPS = 1e-6

kernel_name = "hybrid_gmlp_axialgqa_ecmoe_encoder"


def rms_norm(x, g):
    xf = x.astype(jnp.float32)
    y = xf * lax.rsqrt(jnp.mean(xf * xf, axis=-1, keepdims=True) + EPS)
    return (y * g.astype(jnp.float32)).astype(x.dtype)


def rope_1d(x, pos):
    half = x.shape[-1] // 2
    inv_freq = ROPE_BASE ** (-jnp.arange(half, dtype=jnp.float32) / half)
    ang = pos.astype(jnp.float32)[:, None] * inv_freq[None, :]
    cos = jnp.cos(ang)[:, None, :]
    sin = jnp.sin(ang)[:, None, :]
    xf = x.astype(jnp.float32)
    x1, x2 = xf[..., :half], xf[..., half:]
    return jnp.concatenate([x1 * cos - x2 * sin, x2 * cos + x1 * sin], axis=-1).astype(x.dtype)


def axial_rope(x, row_pos, col_pos):
    d_axis = x.shape[-1] // 2
    return jnp.concatenate([rope_1d(x[..., :d_axis], row_pos),
                            rope_1d(x[..., d_axis:], col_pos)], axis=-1)


def chunked_spatial_gating(u, v, g_v, w_s, b_s):
    B, S, _ = u.shape
    n_chunks = S // CHUNK
    u = jax.nn.gelu(u).reshape(B, n_chunks, CHUNK, A_HEADS, HEAD_DIM)
    v = rms_norm(jax.nn.gelu(v).reshape(B, S, A_HEADS, HEAD_DIM), g_v)
    v = v.reshape(B, n_chunks, CHUNK, A_HEADS, HEAD_DIM)
    gate = jnp.einsum('hpq,bnqhd->bnphd', w_s, v) + b_s.T[None, None, :, :, None]
    return (u * gate).reshape(B, S, A_WIDTH)


def grid_attention(q, k, v, g_q, g_k):
    B, S, _ = q.shape
    rows = S // GRID_W
    row_pos = jnp.repeat(jnp.arange(rows, dtype=jnp.int32), GRID_W)
    col_pos = jnp.tile(jnp.arange(GRID_W, dtype=jnp.int32), rows)
    q = rms_norm(q.reshape(B, S, B_HEADS, HEAD_DIM), g_q)
    k = rms_norm(k.reshape(B, S, B_KV_HEADS, HEAD_DIM), g_k)
    v = v.reshape(B, S, B_KV_HEADS, HEAD_DIM)
    q = axial_rope(q, row_pos, col_pos)
    k = axial_rope(k, row_pos, col_pos)
    n_blocks = S // Q_BLOCK
    q = q.reshape(B, n_blocks, Q_BLOCK, B_KV_HEADS, B_GROUP, HEAD_DIM).transpose(1, 0, 2, 3, 4, 5)
    scale = HEAD_DIM ** -0.5

    def attend_block(qb):
        s = jnp.einsum('bqkgd,bskd->bkgqs', qb, k, preferred_element_type=jnp.float32) * scale
        p = jax.nn.softmax(s, axis=-1)
        return jnp.einsum('bkgqs,bskd->bqkgd', p.astype(v.dtype), v)

    o = lax.map(attend_block, q)
    return o.transpose(1, 0, 2, 3, 4, 5).reshape(B, S, B_WIDTH)


def expert_choice_ffn(h, w_router, w_gate, w_up, w_down):
    B, S, D = h.shape
    cap = CAPACITY_FACTOR * S // N_EXPERTS
    logits = jnp.einsum('bsd,de->bse', h, w_router, preferred_element_type=jnp.float32)
    affinity = jax.nn.softmax(logits, axis=-1)
    g, idx = lax.top_k(affinity.transpose(0, 2, 1), cap)
    b_idx = jnp.arange(B)[:, None, None]
    xs = h[b_idx, idx]
    a = jnp.einsum('becd,edf->becf', xs, w_gate)
    b = jnp.einsum('becd,edf->becf', xs, w_up)
    y = jnp.einsum('becf,efd->becd', jax.nn.silu(a) * b, w_down)
    y = y * g[..., None].astype(y.dtype)
    return jnp.zeros_like(h).at[b_idx, idx].add(y)


def setup_inputs(seed: int = 0) -> dict:
    key = jax.random.key(seed)
    ks = jax.random.split(key, 20)
    f32 = jnp.float32
    n = lambda k, shape, s: jax.random.normal(k, shape, f32) * s
    gain = lambda k, shape: 1.0 + 0.01 * jax.random.normal(k, shape, f32)
    return {
        "x": jax.random.normal(ks[0], (BATCH, SEQ, D_MODEL), f32),
        "norm_mix_g": gain(ks[1], (DEPTH, D_MODEL)),
        "w_in": n(ks[2], (DEPTH, D_MODEL, IN_WIDTH), D_MODEL ** -0.5),
        "gmlp_v_norm_g": gain(ks[3], (DEPTH, A_HEADS, HEAD_DIM)),
        "gmlp_w_s": n(ks[4], (DEPTH, A_HEADS, CHUNK, CHUNK), CHUNK ** -0.5),
        "gmlp_b_s": 1.0 + 0.1 * jax.random.normal(ks[5], (DEPTH, A_HEADS, CHUNK), f32),
        "q_norm_g": gain(ks[6], (DEPTH, HEAD_DIM)),
        "k_norm_g": gain(ks[7], (DEPTH, HEAD_DIM)),
        "group_norm_a_g": gain(ks[8], (DEPTH, A_WIDTH)),
        "group_norm_b_g": gain(ks[9], (DEPTH, B_WIDTH)),
        "w_out": n(ks[10], (DEPTH, D_MIX, D_MODEL), D_MIX ** -0.5),
        "norm_ffn_g": gain(ks[11], (DEPTH, D_MODEL)),
        "w_router": n(ks[12], (DEPTH, D_MODEL, N_EXPERTS), D_MODEL ** -0.5),
        "w_gate": n(ks[13], (DEPTH, N_EXPERTS, D_MODEL, EXPERT_FF), D_MODEL ** -0.5),
        "w_up": n(ks[14], (DEPTH, N_EXPERTS, D_MODEL, EXPERT_FF), D_MODEL ** -0.5),
        "w_down": n(ks[15], (DEPTH, N_EXPERTS, EXPERT_FF, D_MODEL), EXPERT_FF ** -0.5),
        "final_norm_g": gain(ks[16], (D_MODEL,)),
    }


def reference(x, norm_mix_g, w_in, gmlp_v_norm_g, gmlp_w_s, gmlp_b_s, q_norm_g, k_norm_g,
              group_norm_a_g, group_norm_b_g, w_out, norm_ffn_g, w_router, w_gate, w_up,
              w_down, final_norm_g):
    o_u = 0
    o_v = o_u + A_WIDTH
    o_q = o_v + A_WIDTH
    o_k = o_q + B_WIDTH
    o_vv = o_k + KV_WIDTH
    for l in range(DEPTH):
        h = rms_norm(x, norm_mix_g[l])
        p = jnp.einsum('bsd,dn->bsn', h, w_in[l])
        a_out = chunked_spatial_gating(p[..., o_u:o_v], p[..., o_v:o_q],
                                       gmlp_v_norm_g[l], gmlp_w_s[l], gmlp_b_s[l])
        b_out = grid_attention(p[..., o_q:o_k], p[..., o_k:o_vv], p[..., o_vv:],
                               q_norm_g[l], k_norm_g[l])
        mixed = jnp.concatenate([rms_norm(a_out, group_norm_a_g[l]),
                                 rms_norm(b_out, group_norm_b_g[l])], axis=-1)
        x = x + jnp.einsum('bsm,md->bsd', mixed, w_out[l])
        h2 = rms_norm(x, norm_ffn_g[l])
        x = x + expert_choice_ffn(h2, w_router[l], w_gate[l], w_up[l], w_down[l])
    return rms_norm(x, final_norm_g)
```

```cpp
#include <hip/hip_runtime.h>
#include <cstdint>
#include <cstdio>

constexpr int BATCH = 16, SEQ = 2048, DM = 1024, T = BATCH * SEQ;
constexpr int HD = 64, AH = 8, AW = 512, CHUNK = 128, BH = 8, BKV = 2, BW = 512, KVW = 128, INW = 1792;
constexpr int NE = 16, CAP = 256, EFF = 1024, NSLOT = BATCH * NE * CAP;
constexpr float EPS = 1e-6f;
constexpr float QSCALE = 0.125f * 1.4426950408889634f;

typedef unsigned short bf16;

constexpr size_t MiB = 1u << 20;
constexpr size_t WS_CTL = 0;
constexpr size_t WS_SSB = 1 * MiB;
constexpr size_t WS_RS2 = 2 * MiB;
constexpr size_t WS_AFF = 3 * MiB;
constexpr size_t WS_IDX = 5 * MiB;
constexpr size_t WS_GSEL = 6 * MiB;
constexpr size_t WS_INV = 7 * MiB;
constexpr size_t WS_ROPE = 9 * MiB;
constexpr size_t WS_WIN = 16 * MiB;
constexpr size_t WS_WOUT = 20 * MiB;
constexpr size_t WS_WS = 22 * MiB;
constexpr size_t WS_WGU = 24 * MiB;
constexpr size_t WS_WD = 88 * MiB;
constexpr size_t WS_X1B = 120 * MiB;
constexpr size_t WS_XN = 184 * MiB;
constexpr size_t WS_U = 248 * MiB;
constexpr size_t WS_VG = 280 * MiB;
constexpr size_t WS_Q = 312 * MiB;
constexpr size_t WS_K = 344 * MiB;
constexpr size_t WS_V = 352 * MiB;
constexpr size_t WS_A2 = 360 * MiB;
constexpr size_t WS_HH = 184 * MiB;
constexpr size_t WS_Y = 312 * MiB;
constexpr size_t WS_END = 440 * MiB;

__device__ __forceinline__ unsigned f2bf(float f) { unsigned u = __builtin_bit_cast(unsigned, f); return (u + 0x7fffu + ((u >> 16) & 1u)) >> 16; }
__device__ __forceinline__ float bf2f(bf16 h) { return __builtin_bit_cast(float, (unsigned)h << 16); }
__device__ __forceinline__ float gelu_tanh(float x) { return 0.5f * x * (1.0f + tanhf(0.7978845608028654f * (x + 0.044715f * x * x * x))); }
__device__ __forceinline__ float wave_sum(float v) {
#pragma unroll
    for (int o = 1; o < 64; o <<= 1) v += __shfl_xor(v, o);
    return v;
}

__global__ void nv_rope_table(float* rope) {
    const int t = blockIdx.x * blockDim.x + threadIdx.x;
    if (t >= 64 * 16) return;
    const int pos = t / 16, i = t % 16;
    const float inv = powf(10000.0f, -(float)i / 16.0f);
    const float ang = (float)pos * inv;
    rope[2 * t] = cosf(ang); rope[2 * t + 1] = sinf(ang);
}
__global__ void nv_fill_i32(int* p, int v, int n) { const int i = blockIdx.x * blockDim.x + threadIdx.x; if (i < n) p[i] = v; }

__global__ void __launch_bounds__(256) nv_xn(const float* __restrict__ x, bf16* __restrict__ xn) {
    const int row = blockIdx.x * 4 + (threadIdx.x >> 6), lane = threadIdx.x & 63;
    const float* xr = x + (size_t)row * DM;
    float v[16]; float ss = 0.f;
#pragma unroll
    for (int i = 0; i < 16; ++i) { v[i] = xr[i * 64 + lane]; ss += v[i] * v[i]; }
    ss = wave_sum(ss);
    const float rstd = rsqrtf(ss * (1.0f / DM) + EPS);
#pragma unroll
    for (int i = 0; i < 16; ++i) xn[(size_t)row * DM + i * 64 + lane] = (bf16)f2bf(v[i] * rstd);
}

template <int NB, class AL, class BL, class EP>
__global__ void __launch_bounds__(256) nv_gemm(AL al, BL bl, EP ep, int K) {
    __shared__ float As[16][68];
    __shared__ float Bs[NB][16][68];
    __shared__ float Ct[NB][64][65];
    const int tid = threadIdx.x, ty = tid >> 4, tx = tid & 15;
    const int row0 = blockIdx.y * 64, col0 = blockIdx.x * 64;
    float acc[NB][4][4];
#pragma unroll
    for (int b = 0; b < NB; ++b)
#pragma unroll
        for (int i = 0; i < 4; ++i)
#pragma unroll
            for (int j = 0; j < 4; ++j) acc[b][i][j] = 0.f;
    for (int k0 = 0; k0 < K; k0 += 16) {
#pragma unroll
        for (int i = 0; i < 4; ++i) { const int e = tid + i * 256, r = e >> 4, kk = e & 15; As[kk][r] = al(row0 + r, k0 + kk); }
#pragma unroll
        for (int b = 0; b < NB; ++b)
#pragma unroll
            for (int i = 0; i < 4; ++i) { const int e = tid + i * 256, kk = e >> 6, c = e & 63; Bs[b][kk][c] = bl(b, k0 + kk, col0 + c, row0); }
        __syncthreads();
#pragma unroll
        for (int kk = 0; kk < 16; ++kk) {
            float a[4];
#pragma unroll
            for (int i = 0; i < 4; ++i) a[i] = As[kk][ty * 4 + i];
#pragma unroll
            for (int b = 0; b < NB; ++b) {
                float bv[4];
#pragma unroll
                for (int j = 0; j < 4; ++j) bv[j] = Bs[b][kk][tx * 4 + j];
#pragma unroll
                for (int i = 0; i < 4; ++i)
#pragma unroll
                    for (int j = 0; j < 4; ++j) acc[b][i][j] += a[i] * bv[j];
            }
        }
        __syncthreads();
    }
#pragma unroll
    for (int b = 0; b < NB; ++b)
#pragma unroll
        for (int i = 0; i < 4; ++i)
#pragma unroll
            for (int j = 0; j < 4; ++j) Ct[b][ty * 4 + i][tx * 4 + j] = acc[b][i][j];
    __syncthreads();
    ep(Ct, row0, col0, tid);
}

struct AL_bf16 { const bf16* A; int lda; __device__ float operator()(int r, int k) const { return bf2f(A[(size_t)r * lda + k]); } };
struct BL_win { const float* w; const float* g; __device__ float operator()(int, int k, int c, int) const { return w[(size_t)k * INW + c] * g[k]; } };
struct EP_inproj {
    bf16 *U, *VG, *Q, *Kb, *Vb; const float *gv, *gq, *gk;
    __device__ void operator()(float (*Ct)[64][65], int row0, int col0, int tid) const {
        const int ct = col0 / 64;
        const int r = tid >> 2, seg = tid & 3;
        const int row = row0 + r;
        float v[16];
#pragma unroll
        for (int j = 0; j < 16; ++j) v[j] = Ct[0][r][seg * 16 + j];
        if (ct < 8) {
#pragma unroll
            for (int j = 0; j < 16; ++j) U[(size_t)row * AW + ct * 64 + seg * 16 + j] = (bf16)f2bf(gelu_tanh(v[j]));
        } else if (ct < 16) {
            const int h = ct - 8; float ss = 0.f;
#pragma unroll
            for (int j = 0; j < 16; ++j) { v[j] = gelu_tanh(v[j]); ss += v[j] * v[j]; }
            ss += __shfl_xor(ss, 1); ss += __shfl_xor(ss, 2);
            const float rstd = rsqrtf(ss * (1.0f / 64.0f) + EPS);
#pragma unroll
            for (int j = 0; j < 16; ++j) VG[(size_t)row * AW + h * 64 + seg * 16 + j] = (bf16)f2bf(v[j] * rstd * gv[h * 64 + seg * 16 + j]);
        } else if (ct < 26) {
            const bool isq = ct < 24; const int h = isq ? ct - 16 : ct - 24; const float* g = isq ? gq : gk;
            float ss = 0.f;
#pragma unroll
            for (int j = 0; j < 16; ++j) ss += v[j] * v[j];
            ss += __shfl_xor(ss, 1); ss += __shfl_xor(ss, 2);
            const float rstd = rsqrtf(ss * (1.0f / 64.0f) + EPS);
            const int t = row % SEQ; const int pos = (seg < 2) ? (t / 64) : (t % 64);
#pragma unroll
            for (int j = 0; j < 16; ++j) {
                const int d = seg * 16 + j, pd = (seg ^ 1) * 16 + j;
                const float me = v[j] * rstd * g[d], pa = Ct[0][r][pd] * rstd * g[pd];
                const float inv = powf(10000.0f, -(float)j / 16.0f), ang = (float)pos * inv;
                const float c = cosf(ang), s = sinf(ang);
                const float o = (seg & 1) ? (me * c + pa * s) : (me * c - pa * s);
                if (isq) Q[(size_t)row * BW + h * 64 + d] = (bf16)f2bf(o * QSCALE);
                else Kb[(size_t)row * KVW + h * 64 + d] = (bf16)f2bf(o);
            }
        } else {
            const int h = ct - 26;
#pragma unroll
            for (int j = 0; j < 16; ++j) Vb[(size_t)row * KVW + h * 64 + seg * 16 + j] = (bf16)f2bf(v[j]);
        }
    }
};

__global__ void __launch_bounds__(256) nv_attn(const bf16* __restrict__ Q, const bf16* __restrict__ Kb, const bf16* __restrict__ Vb, bf16* __restrict__ A2, float* __restrict__ SSB) {
    __shared__ float Ks[64][64];
    __shared__ float Vs[64][64];
    const int tid = threadIdx.x, qb = blockIdx.x, hq = blockIdx.y, b = blockIdx.z, hk = hq >> 2;
    const size_t row = (size_t)b * SEQ + qb * 256 + tid;
    float q[64], o[64];
#pragma unroll
    for (int d = 0; d < 64; ++d) { q[d] = bf2f(Q[row * BW + hq * 64 + d]); o[d] = 0.f; }
    float m = -1e30f, l = 0.f;
    for (int kt = 0; kt < SEQ / 64; ++kt) {
        __syncthreads();
#pragma unroll
        for (int i = 0; i < 16; ++i) { const int e = tid + i * 256, key = e >> 6, d = e & 63; const size_t kr = (size_t)b * SEQ + kt * 64 + key;
            Ks[key][d] = bf2f(Kb[kr * KVW + hk * 64 + d]); Vs[key][d] = bf2f(Vb[kr * KVW + hk * 64 + d]); }
        __syncthreads();
        for (int key = 0; key < 64; ++key) {
            float s = 0.f;
#pragma unroll
            for (int d = 0; d < 64; ++d) s += q[d] * Ks[key][d];
            const float mn = fmaxf(m, s), corr = exp2f(m - mn), p = exp2f(s - mn);
            l = l * corr + p; m = mn;
#pragma unroll
            for (int d = 0; d < 64; ++d) o[d] = o[d] * corr + p * Vs[key][d];
        }
    }
    const float il = 1.0f / l; float ss = 0.f;
#pragma unroll
    for (int d = 0; d < 64; ++d) { const float ov = o[d] * il; ss += ov * ov; A2[row * DM + 512 + hq * 64 + d] = (bf16)f2bf(ov); }
    SSB[row * 8 + hq] = ss;
}

__global__ void __launch_bounds__(512) nv_gmlp(const bf16* __restrict__ U, const bf16* __restrict__ VG, const float* __restrict__ ws, const float* __restrict__ bs, const float* __restrict__ SSB, bf16* __restrict__ A2) {
    __shared__ float red[8];
    const int tid = threadIdx.x, h = tid >> 6, d = tid & 63;
    const int row = blockIdx.x, b = row / SEQ, s = row % SEQ, ch = s / CHUNK, p = s % CHUNK;
    const size_t base = (size_t)b * SEQ + ch * CHUNK;
    float gate = bs[h * CHUNK + p];
    const float* wr = ws + ((size_t)h * CHUNK + p) * CHUNK;
    for (int q = 0; q < CHUNK; ++q) gate += wr[q] * bf2f(VG[(base + q) * AW + h * 64 + d]);
    const float a = bf2f(U[(size_t)row * AW + tid]) * gate;
    float ss = wave_sum(a * a);
    if ((tid & 63) == 0) red[h] = ss;
    __syncthreads();
    float tot = 0.f, sb = 0.f;
#pragma unroll
    for (int i = 0; i < 8; ++i) { tot += red[i]; sb += SSB[(size_t)row * 8 + i]; }
    const float rstd_a = rsqrtf(tot * (1.0f / AW) + EPS), rstd_b = rsqrtf(sb * (1.0f / BW) + EPS);
    A2[(size_t)row * DM + tid] = (bf16)f2bf(a * rstd_a / rstd_b);
}

struct BL_wout { const float* w; const float* ga; const float* gb; __device__ float operator()(int, int k, int c, int) const { return w[(size_t)k * DM + c] * (k < 512 ? ga[k] : gb[k - 512]); } };
struct EP_outproj {
    const float* x; const float* SSB; float* X1; bf16* X1B;
    __device__ void operator()(float (*Ct)[64][65], int row0, int col0, int tid) const {
        const int r = tid >> 2, seg = tid & 3; const size_t row = row0 + r;
        float sb = 0.f;
#pragma unroll
        for (int i = 0; i < 8; ++i) sb += SSB[row * 8 + i];
        const float rstd_b = rsqrtf(sb * (1.0f / BW) + EPS);
#pragma unroll
        for (int j = 0; j < 16; ++j) { const int c = col0 + seg * 16 + j; const float v = x[row * DM + c] + rstd_b * Ct[0][r][seg * 16 + j]; X1[row * DM + c] = v; X1B[row * DM + c] = (bf16)f2bf(v); }
    }
};

__global__ void __launch_bounds__(256) nv_router(const float* __restrict__ X1, const float* __restrict__ gf, const float* __restrict__ wr, float* __restrict__ AFF, float* __restrict__ RS2) {
    const int row = blockIdx.x * 4 + (threadIdx.x >> 6), lane = threadIdx.x & 63;
    float lg[16]; float ss = 0.f;
#pragma unroll
    for (int e = 0; e < 16; ++e) lg[e] = 0.f;
#pragma unroll
    for (int i = 0; i < 16; ++i) { const int c = i * 64 + lane; const float xv = X1[(size_t)row * DM + c]; ss += xv * xv; const float hv = xv * gf[c];
#pragma unroll
        for (int e = 0; e < 16; ++e) lg[e] += hv * wr[c * 16 + e]; }
    ss = wave_sum(ss);
    const float rstd = rsqrtf(ss * (1.0f / DM) + EPS);
    float mx = -1e30f;
#pragma unroll
    for (int e = 0; e < 16; ++e) { lg[e] = wave_sum(lg[e]) * rstd; mx = fmaxf(mx, lg[e]); }
    float den = 0.f;
#pragma unroll
    for (int e = 0; e < 16; ++e) { lg[e] = expf(lg[e] - mx); den += lg[e]; }
    const float id = 1.0f / den;
    const int b = row / SEQ, s = row % SEQ;
    float mine = 0.f;
#pragma unroll
    for (int e = 0; e < 16; ++e) if (lane == e) mine = lg[e] * id;
    if (lane < 16) AFF[((size_t)b * NE + lane) * SEQ + s] = mine;
    if (lane == 0) RS2[row] = rstd;
}

__global__ void __launch_bounds__(512) nv_topk(const float* __restrict__ AFF, int* __restrict__ IDX, float* __restrict__ GSEL, int* __restrict__ INV) {
    __shared__ float av[SEQ];
    const int be = blockIdx.x, b = be / NE, e = be % NE, tid = threadIdx.x;
#pragma unroll
    for (int i = 0; i < 4; ++i) av[tid + i * 512] = AFF[(size_t)be * SEQ + tid + i * 512];
    __syncthreads();
#pragma unroll
    for (int i = 0; i < 4; ++i) {
        const int s = tid + i * 512; const float v = av[s]; int rank = 0;
        for (int j = 0; j < SEQ; ++j) { const float w = av[j]; rank += (w > v || (w == v && j < s)) ? 1 : 0; }
        if (rank < CAP) { IDX[be * CAP + rank] = b * SEQ + s; GSEL[be * CAP + rank] = v; INV[((size_t)b * SEQ + s) * NE + e] = rank; }
    }
}

struct AL_gather { const bf16* A; const int* idx; __device__ float operator()(int r, int k) const { return bf2f(A[(size_t)idx[r] * DM + k]); } };
struct BL_gu { const float* wg; const float* wu; const float* g; __device__ float operator()(int b, int k, int c, int row0) const { const int e = (row0 / CAP) % NE; const float* w = b ? wu : wg; return w[((size_t)e * DM + k) * EFF + c] * g[k]; } };
struct EP_gu {
    const int* idx; const float* RS2; bf16* HH;
    __device__ void operator()(float (*Ct)[64][65], int row0, int col0, int tid) const {
        const int r = tid >> 2, seg = tid & 3; const size_t row = row0 + r; const float rs = RS2[idx[row]];
#pragma unroll
        for (int j = 0; j < 16; ++j) { const float a = Ct[0][r][seg * 16 + j] * rs, bb = Ct[1][r][seg * 16 + j] * rs; const float hv = a / (1.0f + expf(-a)) * bb; HH[row * EFF + col0 + seg * 16 + j] = (bf16)f2bf(hv); }
    }
};
struct BL_down { const float* wd; __device__ float operator()(int, int k, int c, int row0) const { const int e = (row0 / CAP) % NE; return wd[((size_t)e * EFF + k) * DM + c]; } };
struct EP_down {
    const float* GSEL; bf16* Y;
    __device__ void operator()(float (*Ct)[64][65], int row0, int col0, int tid) const {
        const int r = tid >> 2, seg = tid & 3; const size_t row = row0 + r; const float g = GSEL[row];
#pragma unroll
        for (int j = 0; j < 16; ++j) Y[row * DM + col0 + seg * 16 + j] = (bf16)f2bf(Ct[0][r][seg * 16 + j] * g);
    }
};

__global__ void __launch_bounds__(256) nv_final(float* __restrict__ X1out, const bf16* __restrict__ Y, const int* __restrict__ INV, const float* __restrict__ gfin) {
    const int row = blockIdx.x * 4 + (threadIdx.x >> 6), lane = threadIdx.x & 63, b = row / SEQ;
    float v[16];
#pragma unroll
    for (int i = 0; i < 16; ++i) v[i] = X1out[(size_t)row * DM + i * 64 + lane];
    for (int e = 0; e < NE; ++e) {
        const int c = INV[(size_t)row * NE + e];
        if (c >= 0) { const bf16* yr = Y + ((size_t)(b * NE + e) * CAP + c) * DM;
#pragma unroll
            for (int i = 0; i < 16; ++i) v[i] += bf2f(yr[i * 64 + lane]); }
    }
    float ss = 0.f;
#pragma unroll
    for (int i = 0; i < 16; ++i) ss += v[i] * v[i];
    ss = wave_sum(ss);
    const float rstd = rsqrtf(ss * (1.0f / DM) + EPS);
#pragma unroll
    for (int i = 0; i < 16; ++i) X1out[(size_t)row * DM + i * 64 + lane] = v[i] * rstd * gfin[i * 64 + lane];
}

extern "C" void kernel_launch(void* const* d_in, const int* in_sizes, int n_in, void* d_out, int out_size, void* d_ws, size_t ws_size, hipStream_t stream) {
    if (n_in != 17 || in_sizes[0] != T * DM || out_size != T * DM || ws_size < WS_END) { fprintf(stderr, "kernel_launch: unexpected shapes / workspace (%d inputs, ws %zu)\n", n_in, ws_size); return; }
    const float* x = (const float*)d_in[0]; const float* g_mix = (const float*)d_in[1]; const float* w_in = (const float*)d_in[2];
    const float* g_v = (const float*)d_in[3]; const float* w_s = (const float*)d_in[4]; const float* b_s = (const float*)d_in[5];
    const float* g_q = (const float*)d_in[6]; const float* g_k = (const float*)d_in[7]; const float* g_a = (const float*)d_in[8]; const float* g_b = (const float*)d_in[9];
    const float* w_out = (const float*)d_in[10]; const float* g_ffn = (const float*)d_in[11]; const float* w_router = (const float*)d_in[12];
    const float* w_gate = (const float*)d_in[13]; const float* w_up = (const float*)d_in[14]; const float* w_down = (const float*)d_in[15]; const float* g_fin = (const float*)d_in[16];
    unsigned char* ws = (unsigned char*)d_ws; float* out = (float*)d_out;
    float* SSB = (float*)(ws + WS_SSB); float* RS2 = (float*)(ws + WS_RS2); float* AFF = (float*)(ws + WS_AFF);
    int* IDX = (int*)(ws + WS_IDX); float* GSEL = (float*)(ws + WS_GSEL); int* INV = (int*)(ws + WS_INV);
    bf16* X1B = (bf16*)(ws + WS_X1B); bf16* XN = (bf16*)(ws + WS_XN); bf16* U = (bf16*)(ws + WS_U); bf16* VG = (bf16*)(ws + WS_VG);
    bf16* Q = (bf16*)(ws + WS_Q); bf16* Kb = (bf16*)(ws + WS_K); bf16* Vb = (bf16*)(ws + WS_V); bf16* A2 = (bf16*)(ws + WS_A2);
    bf16* HH = (bf16*)(ws + WS_HH); bf16* Y = (bf16*)(ws + WS_Y);

    nv_fill_i32<<<(T * NE + 255) / 256, 256, 0, stream>>>(INV, -1, T * NE);
    nv_xn<<<T / 4, 256, 0, stream>>>(x, XN);
    nv_gemm<1><<<dim3(INW / 64, T / 64), 256, 0, stream>>>(AL_bf16{XN, DM}, BL_win{w_in, g_mix}, EP_inproj{U, VG, Q, Kb, Vb, g_v, g_q, g_k}, DM);
    nv_attn<<<dim3(SEQ / 256, BH, BATCH), 256, 0, stream>>>(Q, Kb, Vb, A2, SSB);
    nv_gmlp<<<T, 512, 0, stream>>>(U, VG, w_s, b_s, SSB, A2);
    nv_gemm<1><<<dim3(DM / 64, T / 64), 256, 0, stream>>>(AL_bf16{A2, DM}, BL_wout{w_out, g_a, g_b}, EP_outproj{x, SSB, out, X1B}, DM);
    nv_router<<<T / 4, 256, 0, stream>>>(out, g_ffn, w_router, AFF, RS2);
    nv_topk<<<BATCH * NE, 512, 0, stream>>>(AFF, IDX, GSEL, INV);
    nv_gemm<2><<<dim3(EFF / 64, NSLOT / 64), 256, 0, stream>>>(AL_gather{X1B, IDX}, BL_gu{w_gate, w_up, g_ffn}, EP_gu{IDX, RS2, HH}, DM);
    nv_gemm<1><<<dim3(DM / 64, NSLOT / 64), 256, 0, stream>>>(AL_bf16{HH, EFF}, BL_down{w_down}, EP_down{GSEL, Y}, EFF);
    nv_final<<<T / 4, 256, 0, stream>>>(out, Y, INV, g_fin);
}
```

```cpp
#include <hip/hip_runtime.h>
#include <hip/hip_bf16.h>
#include <cstdint>
#include <cstdio>

constexpr int BATCH = 16, SEQ = 2048, DM = 1024, T = BATCH * SEQ;
constexpr int HD = 64, AH = 8, AW = 512, CHUNK = 128, BH = 8, BKV = 2, BW = 512, KVW = 128, INW = 1792;
constexpr int NE = 16, CAP = 256, EFF = 1024, NSLOT = BATCH * NE * CAP;
constexpr float EPS = 1e-6f;
constexpr float QSCALE = 0.125f * 1.4426950408889634f;

typedef unsigned short bf16;

constexpr size_t MiB = 1u << 20;
constexpr size_t WS_CTL = 0;
constexpr size_t WS_SSB = 1 * MiB;
constexpr size_t WS_RS2 = 2 * MiB;
constexpr size_t WS_AFF = 3 * MiB;
constexpr size_t WS_IDX = 5 * MiB;
constexpr size_t WS_GSEL = 6 * MiB;
constexpr size_t WS_INV = 7 * MiB;
constexpr size_t WS_ROPE = 9 * MiB;
constexpr size_t WS_WIN = 16 * MiB;
constexpr size_t WS_WOUT = 20 * MiB;
constexpr size_t WS_WS = 22 * MiB;
constexpr size_t WS_WGU = 24 * MiB;
constexpr size_t WS_WD = 88 * MiB;
constexpr size_t WS_X1B = 120 * MiB;
constexpr size_t WS_XN = 184 * MiB;
constexpr size_t WS_U = 248 * MiB;
constexpr size_t WS_VG = 280 * MiB;
constexpr size_t WS_Q = 312 * MiB;
constexpr size_t WS_K = 344 * MiB;
constexpr size_t WS_V = 352 * MiB;
constexpr size_t WS_A2 = 360 * MiB;
constexpr size_t WS_HH = 184 * MiB;
constexpr size_t WS_Y = 312 * MiB;
constexpr size_t WS_END = 440 * MiB;

__device__ __forceinline__ unsigned f2bf(float f) { unsigned u = __builtin_bit_cast(unsigned, f); return (u + 0x7fffu + ((u >> 16) & 1u)) >> 16; }
__device__ __forceinline__ float bf2f(bf16 h) { return __builtin_bit_cast(float, (unsigned)h << 16); }
__device__ __forceinline__ float gelu_tanh(float x) { return 0.5f * x * (1.0f + tanhf(0.7978845608028654f * (x + 0.044715f * x * x * x))); }
__device__ __forceinline__ float wave_sum(float v) {
#pragma unroll
    for (int o = 1; o < 64; o <<= 1) v += __shfl_xor(v, o);
    return v;
}

namespace pg8 {
#define PG8_LAS __attribute__((address_space(3)))
typedef unsigned short bf16_t;
typedef short bf16x8 __attribute__((ext_vector_type(8)));
typedef float f32x4 __attribute__((ext_vector_type(4)));
typedef unsigned u32x4 __attribute__((ext_vector_type(4)));
typedef unsigned u32x2 __attribute__((ext_vector_type(2)));
constexpr int BM = 256, BK = 64, HALF = 128, HTB = HALF * BK * 2  , STAGE_BYTES = 8 * HTB, NXCD = 8, WGM = 8;

__host__ __device__ __forceinline__ int lds_byte(int r, int c) { const int st = (r >> 4) * 2 + (c >> 5), rr = r & 15, cc = c & 31, ob = rr * 64 + cc * 2; return st * 1024 + (ob ^ (((ob >> 9) & 1) << 5)); }
__host__ __device__ __forceinline__ void stage_rc(int b, int& R, int& C) { const int st = b / 1024, sb = b % 1024, swz = sb ^ (((sb >> 9) & 1) << 5); R = (st >> 1) * 16 + swz / 64; C = (st & 1) * 32 + (swz % 64) / 2; }
__host__ __device__ __forceinline__ int perm32(int rho) { const int n = rho >> 4, i = rho & 15; return 8 * (i >> 2) + 4 * n + (i & 3); }

struct Unit { int pm, pn; };

struct StaticOrder {
    int nM, nN, nwg, G, c;
    __host__ __device__ void init(int M, int N, int G_, int c_) { nM = M / BM; nN = N / BM; nwg = nM * nN; G = G_; c = c_; }
    __host__ __device__ bool next(int i, Unit& u) const {
        const long L = (long)i * G + c; if (L >= nwg) return false;
        int wgid = (int)L; { const int q = nwg / NXCD, r = nwg % NXCD, xcd = wgid % NXCD, off = wgid / NXCD; wgid = (xcd < r ? xcd * (q + 1) : r * (q + 1) + (xcd - r) * q) + off; }
        const int nig = WGM * nN, gid = wgid / nig, fm = gid * WGM, gsz = (nM - fm) < WGM ? (nM - fm) : WGM;
        u.pm = fm + ((wgid % nig) % gsz); u.pn = (wgid % nig) / gsz; return true;
    }
};
struct MoeOrder {
    int vcu, G, npn;
    __device__ bool next(int i, Unit& u) const {
        if (G == 256) { if (i >= npn) return false; const int xcd = vcu >> 5, l = vcu & 31, idx = i * 32 + l, per = 16 * npn, ei = idx / per, rem = idx % per;
            u.pm = (rem / npn) * 16 + xcd + 8 * ei; u.pn = rem % npn; return true; }
        const long L = (long)i * G + vcu; if (L >= 256L * npn) return false; u.pm = (int)(L / npn); u.pn = (int)(L % npn); return true;
    }
};

__device__ __forceinline__ unsigned cvt_pk_bf16(float lo, float hi) { unsigned r; asm volatile("v_cvt_pk_bf16_f32 %0, %1, %2" : "=v"(r) : "v"(lo), "v"(hi)); return r; }

template <bool GATHER_> struct Prob {
    static constexpr bool GATHER = GATHER_;
    const bf16_t* A; const bf16_t* Bt; const int* idx; int K; size_t estride;
    __device__ __forceinline__ const char* a_base(const Unit& u) const { return GATHER ? (const char*)A : (const char*)(A + (size_t)u.pm * BM * K); }
    __device__ __forceinline__ const char* b_base(const Unit& u) const { return (const char*)(Bt + (size_t)(u.pm & 15) * estride + (size_t)u.pn * BM * K); }
    __device__ __forceinline__ unsigned a_row(const Unit& u, int r) const { return (unsigned)idx[u.pm * BM + r]; }
};

template <class Epi, class PB, class Sched, bool ALIGN_EPI>
__device__ __forceinline__ void gemm_phase(PG8_LAS unsigned char* lds, const PB g, const Sched& S, const Epi& E) {
    const int tid = threadIdx.x, wid = __builtin_amdgcn_readfirstlane(tid >> 6), lane = tid & 63, wr = wid >> 2, wc = wid & 3, fr = lane & 15, fq = lane >> 4;
    const int K = g.K, nt = K / BK;
    unsigned voffA[2], voffB[2]; int RA[2], CA2[2];
#pragma unroll
    for (int i = 0; i < 2; ++i) { int R, C; stage_rc(tid * 16 + i * 8192, R, C); const int Rb = Epi::PERM ? ((R & ~31) + perm32(R & 31)) : R;
        voffA[i] = (unsigned)(R * K + C) * 2u; voffB[i] = (unsigned)(Rb * K + C) * 2u; RA[i] = R; CA2[i] = C * 2; }
    const size_t kstep = (size_t)(BK * 2);
    const size_t hstep = (size_t)HALF * K * 2;
    const unsigned ldsw = (unsigned)wid * 1024u;
    const int aoff = lds_byte(wr * 64 + fr, fq * 8), boff = lds_byte(wc * 32 + fr, fq * 8);
#define PG8_SA(b, h) (((b) * 2 + (h)) * HTB)
#define PG8_SB(b, h) ((4 + (b) * 2 + (h)) * HTB)
#define PG8_STAGE(bufoff, gbase, voff) do { _Pragma("unroll") for (int _i = 0; _i < 2; ++_i) \
        __builtin_amdgcn_global_load_lds((const unsigned*)((const char*)(gbase) + (voff)[_i]), (PG8_LAS unsigned*)(lds + (bufoff) + ldsw + _i * 8192), 16, 0, 0); } while (0)
#define PG8_STAGE_A(bufoff, gptr, h, VG) do { if constexpr (PB::GATHER) { PG8_STAGE(bufoff, gptr, VG[h]); } else { PG8_STAGE(bufoff, (gptr) + (h) * hstep, voffA); } } while (0)
#define PG8_LDA(dst, b, h) do { _Pragma("unroll") for (int m = 0; m < 4; ++m) _Pragma("unroll") for (int k = 0; k < 2; ++k) dst[m][k] = *(const PG8_LAS bf16x8*)(lds + PG8_SA(b, h) + aoff + m * 2048 + k * 1024); } while (0)
#define PG8_LDB(dst, b, h) do { _Pragma("unroll") for (int n = 0; n < 2; ++n) _Pragma("unroll") for (int k = 0; k < 2; ++k) dst[n][k] = *(const PG8_LAS bf16x8*)(lds + PG8_SB(b, h) + boff + n * 2048 + k * 1024); } while (0)
#define PG8_MMA(ai, bj, At, Bt) do { __builtin_amdgcn_s_setprio(1); _Pragma("unroll") for (int m = 0; m < 4; ++m) _Pragma("unroll") for (int n = 0; n < 2; ++n) _Pragma("unroll") for (int k = 0; k < 2; ++k) \
        acc[ai][bj][m][n] = __builtin_amdgcn_mfma_f32_16x16x32_bf16(Bt[n][k], At[m][k], acc[ai][bj][m][n], 0, 0, 0); __builtin_amdgcn_s_setprio(0); } while (0)
#define PG8_WAIT_V(n) asm volatile("s_waitcnt vmcnt(" #n ")" ::: "memory")
#define PG8_WAIT_L(n) asm volatile("s_waitcnt lgkmcnt(" #n ")" ::: "memory")
#define PG8_BAR __builtin_amdgcn_s_barrier()
#define PG8_SCHED __builtin_amdgcn_sched_barrier(0)
    Unit cur, nxt; int ui = 0;
    if (!S.next(0, cur)) return;
    f32x4 acc[2][2][4][2];
#pragma unroll
    for (int a = 0; a < 2; ++a)
#pragma unroll
        for (int b = 0; b < 2; ++b)
#pragma unroll
            for (int m = 0; m < 4; ++m)
#pragma unroll
                for (int n = 0; n < 2; ++n) acc[a][b][m][n] = (f32x4){0.f, 0.f, 0.f, 0.f};
    bf16x8 At[4][2], B0[2][2], B1[2][2];
    const char* cA = g.a_base(cur); const char* cB = g.b_base(cur);
    unsigned vGc[2][2], vGx[2][2];
    if constexpr (PB::GATHER) {
#pragma unroll
        for (int h = 0; h < 2; ++h)
#pragma unroll
            for (int i = 0; i < 2; ++i) { vGc[h][i] = g.a_row(cur, h * HALF + RA[i]) * (unsigned)(K * 2) + (unsigned)CA2[i]; vGx[h][i] = vGc[h][i]; }
        asm volatile("s_waitcnt vmcnt(0)" ::: "memory");
    }
    PG8_STAGE(PG8_SB(0, 0), cB, voffB); PG8_STAGE(PG8_SB(0, 1), cB + hstep, voffB); PG8_STAGE_A(PG8_SA(0, 0), cA, 0, vGc); PG8_STAGE_A(PG8_SA(0, 1), cA, 1, vGc);
    if (wr == 1) PG8_BAR;
    PG8_WAIT_V(2); PG8_BAR;
    PG8_STAGE(PG8_SB(1, 0), cB + kstep, voffB); PG8_STAGE_A(PG8_SA(1, 0), cA + kstep, 0, vGc); PG8_STAGE(PG8_SB(1, 1), cB + hstep + kstep, voffB);
    PG8_WAIT_V(6); PG8_BAR;
    for (;;) {
        const bool has_next = S.next(ui + 1, nxt);
        const char* nA = has_next ? g.a_base(nxt) : cA; const char* nB = has_next ? g.b_base(nxt) : cB;
        for (int t = 0; t < nt; t += 2) {
            const bool last = (t == nt - 2);
            const char* a1 = cA + (size_t)(t + 1) * kstep;
            const char* a2 = last ? nA : cA + (size_t)(t + 2) * kstep; const char* b2 = last ? nB : cB + (size_t)(t + 2) * kstep;
            const char* a3 = a2 + kstep; const char* b3 = b2 + kstep;
            if constexpr (PB::GATHER) {
                if (last && has_next) {
#pragma unroll
                    for (int h = 0; h < 2; ++h)
#pragma unroll
                        for (int i = 0; i < 2; ++i) vGx[h][i] = g.a_row(nxt, h * HALF + RA[i]) * (unsigned)(K * 2) + (unsigned)CA2[i];
                }
            }
            PG8_LDB(B0, 0, 0); PG8_LDB(B1, 0, 1); PG8_SCHED; PG8_LDA(At, 0, 0); PG8_STAGE_A(PG8_SA(1, 1), a1, 1, vGc);
            PG8_WAIT_V(8); PG8_WAIT_L(0); PG8_BAR; PG8_MMA(0, 0, At, B0); PG8_MMA(0, 1, At, B1); PG8_BAR; PG8_SCHED;
            PG8_LDA(At, 0, 1); PG8_STAGE(PG8_SB(0, 0), b2, voffB); PG8_STAGE(PG8_SB(0, 1), b2 + hstep, voffB); PG8_STAGE_A(PG8_SA(0, 0), a2, 0, vGx);
            PG8_WAIT_V(8); PG8_WAIT_L(0); PG8_BAR; PG8_MMA(1, 0, At, B0); PG8_MMA(1, 1, At, B1); PG8_BAR; PG8_SCHED;
            PG8_LDB(B0, 1, 0); PG8_LDB(B1, 1, 1); PG8_SCHED; PG8_LDA(At, 1, 0); PG8_STAGE_A(PG8_SA(0, 1), a2, 1, vGx);
            PG8_WAIT_V(8); PG8_WAIT_L(0); PG8_BAR; PG8_MMA(0, 0, At, B0); PG8_MMA(0, 1, At, B1); PG8_BAR; PG8_SCHED;
            PG8_LDA(At, 1, 1); PG8_STAGE(PG8_SB(1, 0), b3, voffB); PG8_STAGE(PG8_SB(1, 1), b3 + hstep, voffB); PG8_STAGE_A(PG8_SA(1, 0), a3, 0, vGx);
            PG8_WAIT_V(8); PG8_WAIT_L(0); PG8_BAR; PG8_MMA(1, 0, At, B0); PG8_MMA(1, 1, At, B1); PG8_BAR; PG8_SCHED;
        }
        if constexpr (ALIGN_EPI) { if (wr == 0) PG8_BAR; }
        E(acc, cur, wr, wc, fr, fq);
        if (!has_next) break;
#pragma unroll
        for (int a = 0; a < 2; ++a)
#pragma unroll
            for (int b = 0; b < 2; ++b)
#pragma unroll
                for (int m = 0; m < 4; ++m)
#pragma unroll
                    for (int n = 0; n < 2; ++n) acc[a][b][m][n] = (f32x4){0.f, 0.f, 0.f, 0.f};
        cur = nxt; cA = nA; cB = nB; ++ui;
        if constexpr (PB::GATHER) {
#pragma unroll
            for (int h = 0; h < 2; ++h)
#pragma unroll
                for (int i = 0; i < 2; ++i) vGc[h][i] = vGx[h][i];
        }
        if constexpr (ALIGN_EPI) { if (wr == 1) PG8_BAR; }
    }
    PG8_WAIT_V(0);
    if constexpr (!ALIGN_EPI) { if (wr == 0) PG8_BAR; }
    PG8_BAR;
#undef PG8_SA
#undef PG8_SB
#undef PG8_STAGE
#undef PG8_STAGE_A
#undef PG8_LDA
#undef PG8_LDB
#undef PG8_MMA
#undef PG8_WAIT_V
#undef PG8_WAIT_L
#undef PG8_BAR
#undef PG8_SCHED
}
}
namespace attn_body {
using bf16=__hip_bfloat16;
using bf16x8=__attribute__((ext_vector_type(8)))short;
using s16x4=__attribute__((ext_vector_type(4)))short;
using f32x16=__attribute__((ext_vector_type(16)))float;
using u32x4=__attribute__((ext_vector_type(4)))unsigned;
constexpr int BATCH=16,NHEAD=8,NKV=2,SEQ=2048,D=64,QP=512,KP=128,OP=1024,OCOL=512;
constexpr int NW=8,QBLK=32,QB=QBLK*NW,KVBLK=64,NQB=SEQ/QB;
constexpr int ATTN_UNIT_ROWS=QB;
__device__ __forceinline__ int crow(int r,int hi){return (r&3)+8*(r>>2)+4*hi;}
#define SBAR() __builtin_amdgcn_sched_barrier(0)
__device__ __forceinline__ void cmask(f32x16&p0,f32x16&p1,int jb,int qrel,int hi){
  const float NEG=-INFINITY; int kb=64*jb+4*hi;
  #pragma unroll
  for(int r=0;r<16;++r){int kv=kb+(r&3)+8*(r>>2); if(kv>qrel)p0[r]=NEG; if(kv+32>qrel)p1[r]=NEG;}
}

constexpr int NSLOT=3, SLOTB=8192;
constexpr int LDS_K=0, LDS_V=NSLOT*SLOTB, LDS_WS=2*NSLOT*SLOTB, LDS_OST=LDS_WS+NW*64*4, LDS_BYTES=LDS_OST+NW*4096;
constexpr float C2=0.125f*1.4426950408889634f;
__device__ __forceinline__ void glds16(const void*gsrc,unsigned lds_dst){unsigned keep;
  asm volatile("s_mov_b32 %0, m0\n\ts_mov_b32 m0, %2\n\ts_nop 0\n\tglobal_load_lds_dwordx4 %1, off\n\ts_mov_b32 m0, %0":"=&s"(keep):"v"(gsrc),"s"(lds_dst):"memory");}
__device__ __forceinline__ float max3f(float a,float b,float c){float r;asm("v_max3_f32 %0, %1, %2, %3":"=v"(r):"v"(a),"v"(b),"v"(c));return r;}
__device__ __forceinline__ float max2f(float a,float b){float r;asm("v_max_f32_e32 %0, %1, %2":"=v"(r):"v"(a),"v"(b));return r;}
__device__ __forceinline__ float fadd_s(float a,float b){float r;asm("v_add_f32_e32 %0, %1, %2":"=v"(r):"v"(a),"v"(b));return r;}
__device__ __forceinline__ float fsub_s(float a,float b){float r;asm("v_sub_f32_e32 %0, %1, %2":"=v"(r):"v"(a),"v"(b));return r;}
typedef float f32x2_t __attribute__((ext_vector_type(2))); typedef __bf16 bf16x2_t __attribute__((ext_vector_type(2)));
__device__ __forceinline__ unsigned cvtpk_s(float lo,float hi){f32x2_t v={lo,hi};bf16x2_t b=__builtin_convertvector(v,bf16x2_t);return __builtin_bit_cast(unsigned,b);}
#define WAIT_BAR(N) asm volatile("s_waitcnt vmcnt(" #N ") lgkmcnt(0)\n\ts_barrier":::"memory")

__device__ __forceinline__ void qkt(f32x16&p0,f32x16&p1,const char*Kslot,const bf16x8*qr,const f32x16&negm,int r32,int hi){
  const char*kb=Kslot+hi*1024+r32*16;
  #pragma unroll
  for(int d0=0;d0<4;++d0){
    const bf16x8 b0=*reinterpret_cast<const bf16x8*>(kb+d0*2048);
    const bf16x8 b1=*reinterpret_cast<const bf16x8*>(kb+d0*2048+512);
    if(d0==0){p0=__builtin_amdgcn_mfma_f32_32x32x16_bf16(b0,qr[0],negm,0,0,0);p1=__builtin_amdgcn_mfma_f32_32x32x16_bf16(b1,qr[0],negm,0,0,0);}
    else{p0=__builtin_amdgcn_mfma_f32_32x32x16_bf16(b0,qr[d0],p0,0,0,0);p1=__builtin_amdgcn_mfma_f32_32x32x16_bf16(b1,qr[d0],p1,0,0,0);}}
}
typedef __attribute__((address_space(3))) const char* lds_cptr;
typedef short v4i16_t __attribute__((ext_vector_type(4)));
__device__ __forceinline__ void kload8(bf16x8*kf,lds_cptr kp){
  kf[0]=*(const __attribute__((address_space(3))) bf16x8*)(kp);      kf[1]=*(const __attribute__((address_space(3))) bf16x8*)(kp+512);
  kf[2]=*(const __attribute__((address_space(3))) bf16x8*)(kp+2048); kf[3]=*(const __attribute__((address_space(3))) bf16x8*)(kp+2560);
  kf[4]=*(const __attribute__((address_space(3))) bf16x8*)(kp+4096); kf[5]=*(const __attribute__((address_space(3))) bf16x8*)(kp+4608);
  kf[6]=*(const __attribute__((address_space(3))) bf16x8*)(kp+6144); kf[7]=*(const __attribute__((address_space(3))) bf16x8*)(kp+6656);
}
__device__ __forceinline__ void kload2(bf16x8*kf,lds_cptr kp,int j){ kf[2*j]=*(const __attribute__((address_space(3))) bf16x8*)(kp+j*2048); kf[2*j+1]=*(const __attribute__((address_space(3))) bf16x8*)(kp+j*2048+512); }
__device__ __forceinline__ s16x4 vtr(lds_cptr p){ return __builtin_bit_cast(s16x4,__builtin_amdgcn_ds_read_tr16_b64_v4i16((__attribute__((address_space(3))) v4i16_t*)p)); }
__device__ __forceinline__ float rowmax(const f32x16&p0,const f32x16&p1){
  float a=max3f(p0[0],p0[1],p1[0]),b=max3f(p0[2],p0[3],p1[1]);a=max3f(a,p1[2],p1[3]);
  #pragma unroll
  for(int r=4;r<16;r+=4){a=max3f(a,p0[r],p0[r+1]);b=max3f(b,p0[r+2],p0[r+3]);a=max3f(a,p1[r],p1[r+1]);b=max3f(b,p1[r+2],p1[r+3]);}
  const float m=max2f(a,b);
  auto rr=__builtin_amdgcn_permlane32_swap(__float_as_uint(m),__float_as_uint(m),false,false);
  return max2f(__uint_as_float(rr[0]),__uint_as_float(rr[1]));
}
__device__ __forceinline__ void pv(f32x16*o,int vb,bf16x8 pa0,bf16x8 pa1,bf16x8 pa2,bf16x8 pa3){
  #pragma unroll
  for(int d0=0;d0<2;++d0){s16x4 lo[4],hi[4];
    #pragma unroll
    for(int ks=0;ks<4;++ks){
      asm volatile("ds_read_b64_tr_b16 %0,%1 offset:%c2":"=&v"(lo[ks]):"v"(vb),"i"(d0*4096+ks*1024):"memory");
      asm volatile("ds_read_b64_tr_b16 %0,%1 offset:%c2":"=&v"(hi[ks]):"v"(vb),"i"(d0*4096+ks*1024+512):"memory");}
    asm volatile("s_waitcnt lgkmcnt(0)":::"memory");SBAR();
    #define PK(k) (bf16x8){lo[k][0],lo[k][1],lo[k][2],lo[k][3],hi[k][0],hi[k][1],hi[k][2],hi[k][3]}
    o[d0]=__builtin_amdgcn_mfma_f32_32x32x16_bf16(pa0,PK(0),o[d0],0,0,0);
    o[d0]=__builtin_amdgcn_mfma_f32_32x32x16_bf16(pa1,PK(1),o[d0],0,0,0);
    o[d0]=__builtin_amdgcn_mfma_f32_32x32x16_bf16(pa2,PK(2),o[d0],0,0,0);
    o[d0]=__builtin_amdgcn_mfma_f32_32x32x16_bf16(pa3,PK(3),o[d0],0,0,0);
    #undef PK
  }
}

#ifndef ATTN_STORE16
#define ATTN_STORE16(p,v) (*(u32x4*)(p)=(v))
#endif
template<int THRL> __device__ __forceinline__ void attn_unit(int b,int h,int qb,const bf16*Q,const bf16*__restrict__ K,const bf16*__restrict__ V,bf16*O,float*SSB,char*shm){
  const int tid=threadIdx.x,lane=tid&63,r32=lane&31,hi=lane>>5; const int wid=__builtin_amdgcn_readfirstlane(tid>>6);
  const long rowbase=(long)b*SEQ; const int q0=qb*QB;
  const int hk=h>>2;
  const bf16*Qw=Q+(rowbase+q0+wid*QBLK)*QP+h*D;
  const bf16*Kh=K+rowbase*KP+hk*D,*Vh=V+rowbase*KP+hk*D;
  const unsigned lds0=(unsigned)(uintptr_t)shm;
  float*wsf=(float*)(shm+LDS_WS)+wid*64;
  const bf16*ksrc=Kh+(long)lane*KP+wid*8;
  const bf16*vsrc=Vh+(long)(16*(wid&3)+(lane>>2))*KP+(wid>>2)*32+(lane&3)*8;
  const unsigned kdst=lds0+LDS_K+wid*1024, vdst=lds0+LDS_V+wid*1024;
  #define DMA_K(t,slot) glds16(ksrc+(long)(t)*KVBLK*KP,(unsigned)__builtin_amdgcn_readfirstlane(kdst+(slot)))
  #define DMA_V(t,slot) glds16(vsrc+(long)(t)*KVBLK*KP,(unsigned)__builtin_amdgcn_readfirstlane(vdst+(slot)))
  const int vb0=(int)(lds0+LDS_V)+((lane>>4)&1)*32+(lane&3)*8+(4*hi+((lane&15)>>2))*64;
  const char*Kbase=shm+LDS_K; bf16x8 kf[8];
  const lds_cptr shm3=(lds_cptr)shm; const lds_cptr kp0=shm3+LDS_K+hi*1024+r32*16; const lds_cptr vp0=shm3+LDS_V+((lane>>4)&1)*32+(lane&3)*8+(4*hi+((lane&15)>>2))*64;
  const int NT=SEQ/KVBLK;
  DMA_K(0,0);DMA_V(0,0);DMA_K(1,SLOTB);
  bf16x8 qr[4];
  #pragma unroll
  for(int d0=0;d0<4;++d0)qr[d0]=*reinterpret_cast<const bf16x8*>(&Qw[(long)r32*QP+d0*16+hi*8]);
  float mhat=0.f,l_reg=0.f;f32x16 o[2];o[0]=f32x16{};o[1]=f32x16{};f32x16 negm=f32x16{};asm volatile("":"+v"(negm));
  #define CMASK(P0,P1,t) do{}while(0)
  bool resc=false;
  #define START(P0,P1) do{ const float rm=rowmax(P0,P1); resc=false; \
    { const float dl=rm; mhat=fadd_s(mhat,dl); \
      _Pragma("unroll") for(int r=0;r<16;++r){P0[r]=fsub_s(P0[r],dl);P1[r]=fsub_s(P1[r],dl);} \
      _Pragma("unroll") for(int r=0;r<16;++r)negm[r]=-mhat; asm volatile("":"+v"(negm)); } \
    _Pragma("unroll") for(int r=0;r<16;++r)P0[r]=__builtin_amdgcn_exp2f(P0[r]); }while(0)
  #define RESC() do{ if(resc){ asm volatile("s_waitcnt lgkmcnt(0)":::"memory"); \
      _Pragma("unroll") for(int d_=0;d_<2;++d_) _Pragma("unroll") for(int r=0;r<16;++r)o[d_][r]*=wsf[crow(r,hi)]; } }while(0)
  f32x16 pA0,pA1,pB0,pB1;
  int sl_prev=0,sl_cur=0,sl_next=SLOTB;
  #define ROT() do{sl_prev=sl_cur;sl_cur=sl_next;sl_next=(sl_next==(NSLOT-1)*SLOTB)?0:sl_next+SLOTB;}while(0)
  DMA_K(2,2*SLOTB);
  WAIT_BAR(3);
  qkt(pA0,pA1,Kbase,qr,negm,r32,hi);asm volatile("s_nop 15\n\ts_nop 7":"+v"(pA0),"+v"(pA1));CMASK(pA0,pA1,0);
  START(pA0,pA1);
  _Pragma("unroll") for(int r=0;r<16;++r)pA1[r]=__builtin_amdgcn_exp2f(pA1[r]);
  WAIT_BAR(0);
  DMA_K(3,0);DMA_V(1,SLOTB);
  ROT();
  kload8(kf,kp0+sl_cur);
  WAIT_BAR(2);
  s16x4 vlo[8],vhi[8]; u32x4 pw0,pw1,pw2,pw3;
  #define PKW(P,B) cvtpk_s(P[B],P[B+1])
  #define PAF(k) __builtin_bit_cast(bf16x8,pw##k)
  #define VFR(i) (bf16x8){vlo[i][0],vlo[i][1],vlo[i][2],vlo[i][3],vhi[i][0],vhi[i][1],vhi[i][2],vhi[i][3]}
  #define PIN(x) asm volatile("":"+v"(x))
  #define MX3(a,b,c) __builtin_fmaxf(__builtin_fmaxf((a),(b)),(c))
  #define GAPA(MF,A0,A1,A2,A3,W0,W1,PW) do{ MF; sacc+=A0; sacc+=A1; sacc+=A2; sacc+=A3; PIN(sacc); W0; W1; PIN(PW); SBAR(); }while(0)
  #define EX(v) __builtin_amdgcn_exp2f(v)
  #define GAPB(MF,X,B) do{ MF; X[B]=EX(X[B]); X[B+1]=EX(X[B+1]); X[B+2]=EX(X[B+2]); X[B+3]=EX(X[B+3]); PIN(X); SBAR(); }while(0)
  #define VRD(i) do{ vlo[i]=vtr(vp_+(((i)>>2)*4096+((i)&3)*1024)); vhi[i]=vtr(vp_+(((i)>>2)*4096+((i)&3)*1024+512)); }while(0)
  #define KRD(G,j) do{ if(G){ kload2(kf,kp0+sl_next,j); SBAR(); } }while(0)
  #define STEP(C0,C1,P0,P1,t,GK,GV,GL) do{ SBAR(); \
    const lds_cptr vp_=vp0+sl_prev; \
    VRD(0); SBAR(); float sacc=(P0[0]+P0[1]); \
    GAPA(C0=__builtin_amdgcn_mfma_f32_32x32x16_bf16(kf[0],qr[0],negm,0,0,0), P0[2],P0[3],P0[4],P0[5],     pw0[0]=PKW(P0,0), pw0[1]=PKW(P0,2), pw0); \
    VRD(4); SBAR(); GAPA(C1=__builtin_amdgcn_mfma_f32_32x32x16_bf16(kf[1],qr[0],negm,0,0,0), P0[6],P0[7],P0[8],P0[9],     pw0[2]=PKW(P0,4), pw0[3]=PKW(P0,6), pw0); \
    VRD(1); SBAR(); GAPA(C0=__builtin_amdgcn_mfma_f32_32x32x16_bf16(kf[2],qr[1],C0,0,0,0),   P0[10],P0[11],P0[12],P0[13], pw1[0]=PKW(P0,8), pw1[1]=PKW(P0,10), pw1); \
    VRD(5); SBAR(); GAPA(C1=__builtin_amdgcn_mfma_f32_32x32x16_bf16(kf[3],qr[1],C1,0,0,0),   P0[14],P0[15],P1[0],P1[1],   pw1[2]=PKW(P0,12),pw1[3]=PKW(P0,14), pw1); \
    VRD(2); SBAR(); GAPA(C0=__builtin_amdgcn_mfma_f32_32x32x16_bf16(kf[4],qr[2],C0,0,0,0),   P1[2],P1[3],P1[4],P1[5],     pw2[0]=PKW(P1,0), pw2[1]=PKW(P1,2), pw2); \
    VRD(6); SBAR(); GAPA(C1=__builtin_amdgcn_mfma_f32_32x32x16_bf16(kf[5],qr[2],C1,0,0,0),   P1[6],P1[7],P1[8],P1[9],     pw2[2]=PKW(P1,4), pw2[3]=PKW(P1,6), pw2); \
    VRD(3); SBAR(); GAPA(C0=__builtin_amdgcn_mfma_f32_32x32x16_bf16(kf[6],qr[3],C0,0,0,0),   P1[10],P1[11],P1[12],P1[13], pw3[0]=PKW(P1,8), pw3[1]=PKW(P1,10), pw3); \
    VRD(7); SBAR(); GAPA(C1=__builtin_amdgcn_mfma_f32_32x32x16_bf16(kf[7],qr[3],C1,0,0,0),   P1[14],P1[15],0.f,0.f,       pw3[2]=PKW(P1,12),pw3[3]=PKW(P1,14), pw3); \
    l_reg+=sacc; \
    if(GK){DMA_K((t)+3,sl_cur);} if(GV){DMA_V((t)+1,sl_next);} \
    CMASK(C0,C1,t); \
    { float a=MX3(C0[0],C0[1],C1[0]),b=MX3(C0[2],C0[3],C1[1]); a=MX3(a,C1[2],C1[3]); \
      _Pragma("unroll") for(int r=4;r<16;r+=4){a=MX3(a,C0[r],C0[r+1]);b=MX3(b,C0[r+2],C0[r+3]);a=MX3(a,C1[r],C1[r+1]);b=MX3(b,C1[r+2],C1[r+3]);} \
      float rm=__builtin_fmaxf(a,b); { auto rr=__builtin_amdgcn_permlane32_swap(__float_as_uint(rm),__float_as_uint(rm),false,false); rm=__builtin_fmaxf(__uint_as_float(rr[0]),__uint_as_float(rr[1])); } \
      resc=false; \
      if(__builtin_expect(__any(rm>(float)THRL),0)){ const float dl=__builtin_fmaxf(rm,0.f); mhat+=dl; \
        _Pragma("unroll") for(int r=0;r<16;++r){C0[r]-=dl;C1[r]-=dl;} \
        _Pragma("unroll") for(int r=0;r<16;++r)negm[r]=-mhat; asm volatile("":"+v"(negm)); \
        const float f=__builtin_amdgcn_exp2f(-dl); l_reg*=f; if(hi==0)wsf[r32]=f; resc=true; } } \
    SBAR(); \
    GAPB(o[0]=__builtin_amdgcn_mfma_f32_32x32x16_bf16(PAF(0),VFR(0),o[0],0,0,0), C0,0); \
    GAPB(o[1]=__builtin_amdgcn_mfma_f32_32x32x16_bf16(PAF(0),VFR(4),o[1],0,0,0), C0,4); \
    KRD(GL,0); GAPB(o[0]=__builtin_amdgcn_mfma_f32_32x32x16_bf16(PAF(1),VFR(1),o[0],0,0,0), C0,8); \
    KRD(GL,1); GAPB(o[1]=__builtin_amdgcn_mfma_f32_32x32x16_bf16(PAF(1),VFR(5),o[1],0,0,0), C0,12); \
    KRD(GL,2); GAPB(o[0]=__builtin_amdgcn_mfma_f32_32x32x16_bf16(PAF(2),VFR(2),o[0],0,0,0), C1,0); \
    KRD(GL,3); GAPB(o[1]=__builtin_amdgcn_mfma_f32_32x32x16_bf16(PAF(2),VFR(6),o[1],0,0,0), C1,4); \
    GAPB(o[0]=__builtin_amdgcn_mfma_f32_32x32x16_bf16(PAF(3),VFR(3),o[0],0,0,0), C1,8); \
    GAPB(o[1]=__builtin_amdgcn_mfma_f32_32x32x16_bf16(PAF(3),VFR(7),o[1],0,0,0), C1,12); \
    }while(0)
  int t=1;
  #undef CMASK
  #define CMASK(P0,P1,t) do{}while(0)
  for(;t+5<NT;t+=2){
    STEP(pB0,pB1,pA0,pA1,t,true,true,true);     WAIT_BAR(2); RESC(); ROT();
    STEP(pA0,pA1,pB0,pB1,t+1,true,true,true);   WAIT_BAR(2); RESC(); ROT();
  }
  #undef CMASK
  #define CMASK(P0,P1,t) do{}while(0)
  #define ENDW(tt) do{ if((tt)+3<NT){WAIT_BAR(2);} else if((tt)+2<NT){WAIT_BAR(1);} else {WAIT_BAR(0);} }while(0)
  for(;t+1<NT;t+=2){
    STEP(pB0,pB1,pA0,pA1,t,(t+3<NT),(t+1<NT),(t+1<NT));       ENDW(t);   RESC(); ROT();
    STEP(pA0,pA1,pB0,pB1,t+1,(t+4<NT),(t+2<NT),(t+2<NT));     ENDW(t+1); RESC(); ROT();
  }
  STEP(pB0,pB1,pA0,pA1,NT-1,false,false,false); RESC();
  { float sacc=pB0[0]+pB0[1]; _Pragma("unroll") for(int r=2;r<16;++r)sacc+=pB0[r]; _Pragma("unroll") for(int r=0;r<16;++r)sacc+=pB1[r]; l_reg+=sacc;
    pw0=(u32x4){PKW(pB0,0),PKW(pB0,2),PKW(pB0,4),PKW(pB0,6)};pw1=(u32x4){PKW(pB0,8),PKW(pB0,10),PKW(pB0,12),PKW(pB0,14)};pw2=(u32x4){PKW(pB1,0),PKW(pB1,2),PKW(pB1,4),PKW(pB1,6)};pw3=(u32x4){PKW(pB1,8),PKW(pB1,10),PKW(pB1,12),PKW(pB1,14)};
    SBAR(); pv(o,vb0+sl_cur,PAF(0),PAF(1),PAF(2),PAF(3)); }
  #undef PKW
  #undef PAF
  #undef VFR
  #undef PIN
  #undef MX3
  #undef GAPA
  #undef GAPB
  #undef EX
  #undef VRD
  #undef KRD
  #undef STEP
  #undef ENDW
  {auto rr=__builtin_amdgcn_permlane32_swap(__float_as_uint(l_reg),__float_as_uint(l_reg),false,false);l_reg=__uint_as_float(rr[0])+__uint_as_float(rr[1]);}
  if(hi==0)wsf[32+r32]=l_reg;asm volatile("s_waitcnt lgkmcnt(0)":::"memory");
  float rli[16];
  #pragma unroll
  for(int r=0;r<16;++r)rli[r]=__builtin_amdgcn_rcpf(wsf[32+crow(r,hi)]);
  bf16*Ow=O+(rowbase+q0+wid*QBLK)*OP+OCOL+h*D; float*Sw=SSB+(rowbase+q0+wid*QBLK)*NHEAD+h;
  { bf16*stg=(bf16*)(shm+LDS_OST)+wid*2048;
    #pragma unroll
    for(int r=0;r<16;++r){const int orow=crow(r,hi);
      #pragma unroll
      for(int d0=0;d0<2;++d0)stg[orow*64+d0*32+r32]=__float2bfloat16(o[d0][r]*rli[r]);}
    asm volatile("s_waitcnt lgkmcnt(0)":::"memory");
    #pragma unroll
    for(int i=0;i<4;++i){const int row=i*8+(lane>>3),ch=lane&7; const u32x4 v=*(const u32x4*)(stg+row*64+ch*8); ATTN_STORE16(Ow+(long)row*OP+ch*8,v);
      float ss=0.f;
      #pragma unroll
      for(int j=0;j<4;++j){const float lo=__builtin_bit_cast(float,v[j]<<16),hi2=__builtin_bit_cast(float,v[j]&0xffff0000u); ss+=lo*lo+hi2*hi2;}
      ss+=__shfl_xor(ss,1);ss+=__shfl_xor(ss,2);ss+=__shfl_xor(ss,4); if(ch==0)Sw[(long)row*NHEAD]=ss;} }
  asm volatile("s_waitcnt lgkmcnt(0)\n\ts_barrier":::"memory");
  #undef DMA_K
  #undef DMA_V
  #undef CMASK
  #undef START
  #undef RESC
  #undef ROT
}
constexpr int ATTN_LDS_BYTES=LDS_BYTES;
struct AttnTensors { const bf16* Q; const bf16* K; const bf16* V; bf16* O; float* SSB; };
struct AttnUnit { int bh; int qb; };
struct StaticOrder {
  int vcu,G;
  __device__ __forceinline__ explicit StaticOrder(int grid,int v):vcu(v),G(grid){}
  __device__ __forceinline__ bool next(int i,AttnUnit&u)const{
    if(G==256){ if(i>=4)return false; const int grp=4*(vcu>>5)+i,l=vcu&31; u.bh=(grp>>1)*NHEAD+(grp&1)*4+(l>>3); u.qb=l&7; return true; }
    const long L=(long)i*G+vcu; if(L>=(long)BATCH*NHEAD*NQB)return false; u.bh=(int)(L/NQB); u.qb=(int)(L%NQB); return true; }
};
template<class Sched,int THRL=8> __device__ __forceinline__ void attn_phase(char*lds,const AttnTensors&T,const Sched&S){
  AttnUnit u;
  for(int i=0;S.next(i,u);++i){ attn_unit<THRL>(u.bh/NHEAD,u.bh%NHEAD,u.qb,T.Q,T.K,T.V,T.O,T.SSB,lds); }
}
#undef SBAR
#undef WAIT_BAR
}
#define GAS __attribute__((address_space(1)))
#define LAS __attribute__((address_space(3)))
typedef unsigned v4u __attribute__((ext_vector_type(4)));
typedef float f32x4 __attribute__((ext_vector_type(4)));
typedef short bf16x8 __attribute__((ext_vector_type(8)));
typedef GAS unsigned gu32;
typedef GAS unsigned long long gu64;
#define RLX_AGENT __ATOMIC_RELAXED, __HIP_MEMORY_SCOPE_AGENT
#define LDS_WAIT() asm volatile("s_waitcnt lgkmcnt(0)" ::: "memory")
#define VM_WAIT() asm volatile("s_waitcnt vmcnt(0)" ::: "memory")
__device__ __forceinline__ unsigned long long rt() { return __builtin_amdgcn_s_memrealtime(); }
__device__ __forceinline__ unsigned pk2(float lo, float hi) { return f2bf(lo) | (f2bf(hi) << 16); }

#define XB_TMO      128
#define XB_XCNT(j)  (256  + 64 * (j))
#define XB_XSUB(j)  (1280 + 64 * (j))
#define XB_XGEN(j)  (2304 + 64 * (j))
#define XB_TOP      3328
#define XB_TOPGEN   3392
#define XCD_BAR_WORDS 3456
#define XB_SPIN_CAP (1u << 18)

__device__ __forceinline__ unsigned xb_ld(unsigned* p)              { return __hip_atomic_load(p, __ATOMIC_RELAXED, __HIP_MEMORY_SCOPE_AGENT); }
__device__ __forceinline__ unsigned xb_add(unsigned* p, unsigned v) { return __hip_atomic_fetch_add(p, v, __ATOMIC_RELAXED, __HIP_MEMORY_SCOPE_AGENT); }
__device__ __forceinline__ unsigned xb_xcc_id() { return (unsigned)__builtin_amdgcn_s_getreg((3 << 11) | 20) & 0xFu; }
#define XB_SPIN(cond, bar) do { unsigned _sp = 0; while (cond) { __builtin_amdgcn_s_sleep(1); \
    if ((++_sp & 255u) == 0u) { if (xb_ld(&(bar)[XB_TMO])) break; if (_sp > XB_SPIN_CAP) { atomicAdd(&(bar)[XB_TMO], 1u); break; } } } } while (0)

struct XcdBarrier {
    unsigned* bar; unsigned x;
    volatile LAS unsigned* st;
};

__device__ __forceinline__ XcdBarrier xcd_barrier_post(unsigned* bar, volatile LAS unsigned* st) {
    XcdBarrier b; b.bar = bar; b.x = xb_xcc_id(); b.st = st;
    if (threadIdx.x == 0) (void)xb_add(&bar[XB_XCNT(b.x)], 1u);
    return b;
}
__device__ __forceinline__ void xcd_barrier_complete(unsigned* bar, unsigned x, unsigned& nloc, unsigned& nx) {
    const unsigned G = gridDim.x * gridDim.y * gridDim.z;
    unsigned sum, cnt, mine, sp = 0u;
    for (;;) {
        sum = 0u; cnt = 0u; mine = 0u;
#pragma unroll
        for (unsigned j = 0; j < 16; ++j) { const unsigned c = xb_ld(&bar[XB_XCNT(j)]); sum += c; cnt += (c > 0u) ? 1u : 0u; mine = (j == x) ? c : mine; }
        if (sum == G) break;
        __builtin_amdgcn_s_sleep(1);
        if ((++sp & 255u) == 0u) { if (xb_ld(&bar[XB_TMO])) break; if (sp > XB_SPIN_CAP) { atomicAdd(&bar[XB_TMO], 1u); break; } }
    }
    nloc = mine > 0u ? mine : 1u; nx = cnt > 0u ? cnt : 1u;
}

__device__ __forceinline__ void xcd_barrier(const XcdBarrier& b) {
    asm volatile("s_waitcnt vmcnt(0)" ::: "memory");
    __syncthreads();
    if (threadIdx.x == 0) {
        unsigned* bar = b.bar;
        __builtin_amdgcn_s_waitcnt(0);
        unsigned nloc = b.st[0], nx = b.st[1];
        if (nloc == 0u) { xcd_barrier_complete(bar, b.x, nloc, nx); b.st[0] = nloc; b.st[1] = nx; }
        const unsigned old = xb_add(&bar[XB_XSUB(b.x)], 1u);
        const unsigned gen = old / nloc;
        if (old + 1u == (gen + 1u) * nloc) {
            __builtin_amdgcn_fence(__ATOMIC_RELEASE, "agent");
            asm volatile("s_waitcnt vmcnt(0)" ::: "memory");
            const unsigned og = xb_add(&bar[XB_TOP], 1u);
            const unsigned tg = og / nx;
            if (og + 1u == (tg + 1u) * nx) xb_add(&bar[XB_TOPGEN], 1u);
            else XB_SPIN(xb_ld(&bar[XB_TOPGEN]) == tg, bar);
            __builtin_amdgcn_fence(__ATOMIC_ACQUIRE, "agent");
            xb_add(&bar[XB_XGEN(b.x)], 1u);
            asm volatile("s_waitcnt vmcnt(0)" ::: "memory");
        } else {
            XB_SPIN(xb_ld(&bar[XB_XGEN(b.x)]) == gen, bar);
            __builtin_amdgcn_fence(__ATOMIC_ACQUIRE, "agent");
            asm volatile("s_waitcnt vmcnt(0)" ::: "memory");
        }
    }
    __syncthreads();
}
constexpr int NWAVES = 8;
constexpr int RING_OFF = 0, RING_BYTES = 131072;
constexpr int LDSCTL_OFF = RING_BYTES, MISC_OFF = LDSCTL_OFF + 320;
constexpr int LDS_BYTES = 147456;
constexpr int CW_TMO = 0, CW_CODE = 1, CW_BAR = 4096;
constexpr int N_PHASES = 10;

struct Frame {
    LAS unsigned char* lds;
    volatile LAS unsigned* MISC;
    gu32* ctl;
    int tid, lane, wave, vcu, G;
};
struct Args { const float* in[17]; float* out; unsigned char* ws; int ph_lo, ph_hi, li, pad; };

__device__ __forceinline__ float gelu_fast(float x) {
    const float t = x * (-2.3022082f + -0.10294324f * x * x);
    return x * __builtin_amdgcn_rcpf(1.0f + __builtin_amdgcn_exp2f(t));
}
struct EpiInProj {
    static constexpr bool PERM = true;
    bf16 *U, *VG, *Q, *Kb, *Vb; const float *gv, *gq, *gk, *cosT, *sinT;
    __device__ __forceinline__ void operator()(const pg8::f32x4 (&acc)[2][2][4][2], const pg8::Unit& u, int wr, int wc, int fr, int fq) const {
        using pg8::f32x4; using pg8::u32x4;
        const int pn = u.pn;
        int kind, head;
        if (pn < 2) { kind = 0; head = pn * 4 + wc; } else if (pn < 4) { kind = 1; head = (pn - 2) * 4 + wc; } else if (pn < 6) { kind = 2; head = (pn - 4) * 4 + wc; } else { kind = (wc < 2) ? 3 : 4; head = wc & 1; }
        bf16* outp; int pitch; const float* gp = gq;
        if (kind == 0) { outp = U + head * 64; pitch = AW; } else if (kind == 1) { outp = VG + head * 64; pitch = AW; gp = gv + head * 64; }
        else if (kind == 2) { outp = Q + head * 64; pitch = BW; gp = gq; } else if (kind == 3) { outp = Kb + head * 64; pitch = KVW; gp = gk; } else { outp = Vb + head * 64; pitch = KVW; }
        const int dl = 8 * fq, fi = 8 * (fq & 1);
        f32x4 gg[2][2];
#pragma unroll
        for (int bj = 0; bj < 2; ++bj)
#pragma unroll
            for (int n = 0; n < 2; ++n) gg[bj][n] = *(const f32x4*)(gp + 32 * bj + dl + 4 * n);
#pragma unroll
        for (int ai = 0; ai < 2; ++ai)
#pragma unroll
            for (int m = 0; m < 4; ++m) {
                const int row = u.pm * 256 + ai * 128 + wr * 64 + m * 16 + fr;
                f32x4 v[2][2];
#pragma unroll
                for (int bj = 0; bj < 2; ++bj)
#pragma unroll
                    for (int n = 0; n < 2; ++n) v[bj][n] = acc[ai][bj][m][n];
                if (kind <= 1) {
#pragma unroll
                    for (int bj = 0; bj < 2; ++bj)
#pragma unroll
                        for (int n = 0; n < 2; ++n)
#pragma unroll
                            for (int e = 0; e < 4; ++e) v[bj][n][e] = gelu_fast(v[bj][n][e]);
                }
                if (kind >= 1 && kind <= 3) {
                    float ss = 0.f;
#pragma unroll
                    for (int bj = 0; bj < 2; ++bj)
#pragma unroll
                        for (int n = 0; n < 2; ++n)
#pragma unroll
                            for (int e = 0; e < 4; ++e) ss += v[bj][n][e] * v[bj][n][e];
                    ss += __shfl_xor(ss, 16); ss += __shfl_xor(ss, 32);
                    const float rstd = rsqrtf(ss * (1.0f / 64.0f) + EPS);
#pragma unroll
                    for (int bj = 0; bj < 2; ++bj)
#pragma unroll
                        for (int n = 0; n < 2; ++n) v[bj][n] = v[bj][n] * rstd * gg[bj][n];
                }
                if (kind == 2 || kind == 3) {
                    const int t = row & (SEQ - 1);
                    const float sc = (kind == 2) ? QSCALE : 1.0f;
#pragma unroll
                    for (int bj = 0; bj < 2; ++bj) {
                        const int pos = bj ? (t & 63) : (t >> 6);
#pragma unroll
                        for (int n = 0; n < 2; ++n) {
                            const f32x4 c4 = *(const f32x4*)(cosT + pos * 16 + fi + 4 * n), s4 = *(const f32x4*)(sinT + pos * 16 + fi + 4 * n);
#pragma unroll
                            for (int e = 0; e < 4; ++e) {
                                const float me = v[bj][n][e], pa = __shfl_xor(me, 32);
                                const float o = (fq < 2) ? (me * c4[e] - pa * s4[e]) : (me * c4[e] + pa * s4[e]);
                                v[bj][n][e] = o * sc;
                            }
                        }
                    }
                }
#pragma unroll
                for (int bj = 0; bj < 2; ++bj) {
                    u32x4 w; w.x = pg8::cvt_pk_bf16(v[bj][0][0], v[bj][0][1]); w.y = pg8::cvt_pk_bf16(v[bj][0][2], v[bj][0][3]); w.z = pg8::cvt_pk_bf16(v[bj][1][0], v[bj][1][1]); w.w = pg8::cvt_pk_bf16(v[bj][1][2], v[bj][1][3]);
                    *(u32x4*)(outp + (size_t)row * pitch + 32 * bj + dl) = w;
                }
            }
    }
};


struct EpiOutProj {
    static constexpr bool PERM = true;
    const float* x; const float* SSB; float* X1; bf16* X1B;
    __device__ __forceinline__ void operator()(const pg8::f32x4 (&acc)[2][2][4][2], const pg8::Unit& u, int wr, int wc, int fr, int fq) const {
        using pg8::f32x4; using pg8::u32x4;
        const int col0 = u.pn * 256 + wc * 32 + 8 * fq;
#pragma unroll
        for (int ai = 0; ai < 2; ++ai)
#pragma unroll
            for (int m = 0; m < 4; ++m) {
                const size_t row = (size_t)(u.pm * 256 + ai * 128 + wr * 64 + m * 16 + fr);
                const f32x4 s0 = *(const f32x4*)(SSB + row * 8), s1 = *(const f32x4*)(SSB + row * 8 + 4);
                const float rstd_b = rsqrtf(((s0[0] + s0[1]) + (s0[2] + s0[3]) + (s1[0] + s1[1]) + (s1[2] + s1[3])) * (1.0f / BW) + EPS);
#pragma unroll
                for (int bj = 0; bj < 2; ++bj) {
                    const size_t off = row * DM + col0 + bj * 128;
                    const f32x4 x0 = *(const f32x4*)(x + off), x1 = *(const f32x4*)(x + off + 4);
                    const f32x4 o0 = x0 + acc[ai][bj][m][0] * rstd_b, o1 = x1 + acc[ai][bj][m][1] * rstd_b;
                    *(f32x4*)(X1 + off) = o0; *(f32x4*)(X1 + off + 4) = o1;
                    u32x4 w; w.x = pg8::cvt_pk_bf16(o0[0], o0[1]); w.y = pg8::cvt_pk_bf16(o0[2], o0[3]); w.z = pg8::cvt_pk_bf16(o1[0], o1[1]); w.w = pg8::cvt_pk_bf16(o1[2], o1[3]);
                    *(u32x4*)(X1B + off) = w;
                }
            }
    }
};

struct EpiGateUp {
    static constexpr bool PERM = true;
    const int* IDX; const float* RS2; bf16* HH;
    __device__ __forceinline__ void operator()(const pg8::f32x4 (&acc)[2][2][4][2], const pg8::Unit& u, int wr, int wc, int fr, int fq) const {
        using pg8::f32x4; using pg8::u32x4;
        const int col0 = u.pn * 128 + wc * 32 + 8 * fq;
#pragma unroll
        for (int ai = 0; ai < 2; ++ai)
#pragma unroll
            for (int m = 0; m < 4; ++m) {
                const size_t slot = (size_t)(u.pm * 256 + ai * 128 + wr * 64 + m * 16 + fr);
                const float rs = RS2[IDX[slot]];
                float h[8];
#pragma unroll
                for (int n = 0; n < 2; ++n)
#pragma unroll
                    for (int e = 0; e < 4; ++e) { const float a = acc[ai][0][m][n][e] * rs, b = acc[ai][1][m][n][e] * rs;
                        h[4 * n + e] = a * __builtin_amdgcn_rcpf(1.0f + __builtin_amdgcn_exp2f(-1.4426950408889634f * a)) * b; }
                u32x4 w; w.x = pg8::cvt_pk_bf16(h[0], h[1]); w.y = pg8::cvt_pk_bf16(h[2], h[3]); w.z = pg8::cvt_pk_bf16(h[4], h[5]); w.w = pg8::cvt_pk_bf16(h[6], h[7]);
                *(u32x4*)(HH + slot * EFF + col0) = w;
            }
    }
};
struct EpiDown {
    static constexpr bool PERM = true;
    const float* GSEL; bf16* Y;
    __device__ __forceinline__ void operator()(const pg8::f32x4 (&acc)[2][2][4][2], const pg8::Unit& u, int wr, int wc, int fr, int fq) const {
        using pg8::f32x4; using pg8::u32x4;
        const int col0 = u.pn * 256 + wc * 32 + 8 * fq;
#pragma unroll
        for (int ai = 0; ai < 2; ++ai)
#pragma unroll
            for (int m = 0; m < 4; ++m) {
                const size_t slot = (size_t)(u.pm * 256 + ai * 128 + wr * 64 + m * 16 + fr);
                const float g = GSEL[slot];
#pragma unroll
                for (int bj = 0; bj < 2; ++bj) {
                    const f32x4 o0 = acc[ai][bj][m][0] * g, o1 = acc[ai][bj][m][1] * g;
                    u32x4 w; w.x = pg8::cvt_pk_bf16(o0[0], o0[1]); w.y = pg8::cvt_pk_bf16(o0[2], o0[3]); w.z = pg8::cvt_pk_bf16(o1[0], o1[1]); w.w = pg8::cvt_pk_bf16(o1[2], o1[3]);
                    *(u32x4*)(Y + slot * DM + col0 + bj * 128) = w;
                }
            }
    }
};

__device__ __forceinline__ void p0_item(const float* W, int ldw, const float* gs, int k0, int n0, bf16* WT, int Kp, int prow0, LAS float* scr, int lane) {
#pragma unroll 8
    for (int i = 0; i < 32; ++i) { const int kk = 2 * i + (lane >> 5); float w = W[(size_t)(k0 + kk) * ldw + n0 + (lane & 31)]; if (gs) w *= gs[kk]; scr[kk * 33 + (lane & 31)] = w; }
    LDS_WAIT(); asm volatile("" ::: "memory");
    const int c = lane & 7;
#pragma unroll
    for (int j = 0; j < 4; ++j) { const int n = (lane >> 3) + 8 * j; const LAS float* s = scr + (8 * c) * 33 + n;
        v4u o; o.x = pk2(s[0 * 33], s[1 * 33]); o.y = pk2(s[2 * 33], s[3 * 33]); o.z = pk2(s[4 * 33], s[5 * 33]); o.w = pk2(s[6 * 33], s[7 * 33]);
        *(GAS v4u*)(WT + (size_t)(prow0 + n) * Kp + k0 + 8 * c) = o; }
    LDS_WAIT(); asm volatile("" ::: "memory");
}
__device__ __forceinline__ void p0_prologue(Frame& F, const Args& a) {
    unsigned char* ws = a.ws;
    const float* x = a.in[0]; const float* g_mix = a.in[1]; const float* w_in = a.in[2]; const float* g_a = a.in[8]; const float* g_b = a.in[9]; const float* w_out = a.in[10];
    const float* g_ffn = a.in[11]; const float* w_gate = a.in[13]; const float* w_up = a.in[14]; const float* w_down = a.in[15];
    bf16* Win_t = (bf16*)(ws + WS_WIN); bf16* Wout_t = (bf16*)(ws + WS_WOUT); bf16* Wgu_t = (bf16*)(ws + WS_WGU); bf16* Wd_t = (bf16*)(ws + WS_WD); bf16* XN = (bf16*)(ws + WS_XN);
    LAS float* scr = (LAS float*)(F.lds + RING_OFF + F.wave * 16384);
    const int gw = F.vcu * NWAVES + F.wave, NGW = F.G * NWAVES;
    constexpr int I_IN = (DM / 64) * (INW / 32), I_OUT = (DM / 64) * (DM / 32), I_E = (DM / 64) * (EFF / 32), I_EXP = NE * I_E;
    constexpr int NITEMS = I_IN + I_OUT + 3 * I_EXP;
    for (int it = gw; it < NITEMS; it += NGW) {
        int r = it;
        if (r < I_IN) { const int kb = r / (INW / 32), nb = r % (INW / 32), k0 = 64 * kb, L0 = 32 * nb, j = L0 >> 8, Lt = L0 & 255;
            p0_item(w_in, INW, g_mix + k0, k0, L0, Win_t, DM, 256 * j + 128 * ((Lt & 63) >> 5) + 32 * (Lt >> 6), scr, F.lane); continue; }
        r -= I_IN;
        if (r < I_OUT) { const int kb = r / (DM / 32), nb = r % (DM / 32), k0 = 64 * kb;
            p0_item(w_out, DM, (k0 < AW ? g_a + k0 : g_b + (k0 - AW)), k0, 32 * nb, Wout_t, DM, 32 * nb, scr, F.lane); continue; }
        r -= I_OUT;
        if (r < 2 * I_EXP) { const int up = r >= I_EXP; if (up) r -= I_EXP; const int e = r / I_E, q = r % I_E, kb = q / (EFF / 32), nb = q % (EFF / 32), k0 = 64 * kb, n0 = 32 * nb;
            p0_item((up ? w_up : w_gate) + (size_t)e * DM * EFF, EFF, g_ffn + k0, k0, n0, Wgu_t, DM, e * 2048 + 256 * (n0 >> 7) + 128 * up + (n0 & 127), scr, F.lane); continue; }
        r -= 2 * I_EXP;
        { const int e = r / I_E, q = r % I_E, kb = q / (DM / 32), nb = q % (DM / 32), k0 = 64 * kb, n0 = 32 * nb;
            p0_item(w_down + (size_t)e * EFF * DM, DM, nullptr, k0, n0, Wd_t, EFF, e * DM + n0, scr, F.lane); }
    }
    for (int m = gw; m < T; m += NGW) {
        const GAS f32x4* xr = (const GAS f32x4*)(x + (size_t)m * DM) + F.lane;
        f32x4 v[4]; float s = 0.f;
#pragma unroll
        for (int j = 0; j < 4; ++j) { v[j] = xr[64 * j]; s += (v[j].x * v[j].x + v[j].y * v[j].y) + (v[j].z * v[j].z + v[j].w * v[j].w); }
#pragma unroll
        for (int o = 1; o < 64; o <<= 1) s += __shfl_xor(s, o);
        const float rstd = rsqrtf(s * (1.0f / DM) + EPS);
        GAS unsigned long long* o8 = (GAS unsigned long long*)(XN + (size_t)m * DM) + F.lane;
#pragma unroll
        for (int j = 0; j < 4; ++j) o8[64 * j] = (unsigned long long)pk2(v[j].x * rstd, v[j].y * rstd) | ((unsigned long long)pk2(v[j].z * rstd, v[j].w * rstd) << 32);
    }
    { const float* w_s = a.in[4]; bf16* Wsb = (bf16*)(ws + WS_WS); const int gt0 = (F.vcu * NWAVES + F.wave) * 64 + F.lane;
      for (int i = gt0; i < AH * CHUNK * CHUNK / 4; i += NGW * 64) { const f32x4 w4 = *(const f32x4*)(w_s + 4 * i); *(unsigned long long*)(Wsb + 4 * i) = (unsigned long long)pk2(w4[0], w4[1]) | ((unsigned long long)pk2(w4[2], w4[3]) << 32); } }
    { int* INV = (int*)(ws + WS_INV); const int gt = (F.vcu * NWAVES + F.wave) * 64 + F.lane, NGT = NGW * 64;
      for (int i = gt; i < T * NE / 4; i += NGT) ((GAS v4u*)INV)[i] = (v4u){0xffffffffu, 0xffffffffu, 0xffffffffu, 0xffffffffu};
      if (gt < 64 * 16) { float* cosT = (float*)(ws + WS_ROPE); float* sinT = cosT + 1024; const int pos = gt >> 4, i = gt & 15;
          const float ang = (float)pos * powf(10000.0f, -(float)i / 16.0f); cosT[gt] = cosf(ang); sinT[gt] = sinf(ang); } }
}

constexpr int VTS = 136;
__device__ __forceinline__ void p3_gmlp(Frame& F, const Args& a) {
    unsigned char* ws = a.ws;
    const bf16* U = (const bf16*)(ws + WS_U); const bf16* VG = (const bf16*)(ws + WS_VG); const bf16* Wsb = (const bf16*)(ws + WS_WS); const float* b_s = a.in[5];
    const float* SSB = (const float*)(ws + WS_SSB); bf16* A2 = (bf16*)(ws + WS_A2);
    LAS bf16* vt = (LAS bf16*)(F.lds + RING_OFF);
    const int w = F.wave, l = F.lane, pr = l & 15, dq = l >> 4, tq = F.tid >> 2, tdc = F.tid & 3;
    for (int unit = F.vcu; unit < BATCH * (SEQ / CHUNK); unit += F.G) {
        const size_t row0 = (size_t)unit * CHUNK, row = row0 + 16 * w + pr;
        float av[8][4][4]; float ss = 0.f;
#pragma unroll
        for (int h = 0; h < 8; ++h) {
            __syncthreads();
            { const bf16* src = VG + (row0 + tq) * AW + h * 64 + tdc * 16; const v4u x0 = *(const v4u*)src, x1 = *(const v4u*)(src + 8);
#pragma unroll
              for (int j = 0; j < 4; ++j) { vt[(tdc * 16 + 2 * j) * VTS + tq] = (bf16)(x0[j] & 0xffffu); vt[(tdc * 16 + 2 * j + 1) * VTS + tq] = (bf16)(x0[j] >> 16);
                                            vt[(tdc * 16 + 8 + 2 * j) * VTS + tq] = (bf16)(x1[j] & 0xffffu); vt[(tdc * 16 + 8 + 2 * j + 1) * VTS + tq] = (bf16)(x1[j] >> 16); } }
            __syncthreads();
            bf16x8 bw[4];
#pragma unroll
            for (int ks = 0; ks < 4; ++ks) bw[ks] = *(const bf16x8*)(Wsb + ((size_t)(h * CHUNK + 16 * w + pr) * CHUNK + 32 * ks + 8 * dq));
            const float bias = b_s[h * CHUNK + 16 * w + pr];
#pragma unroll
            for (int mt = 0; mt < 4; ++mt) {
                f32x4 acc = (f32x4){0.f, 0.f, 0.f, 0.f};
#pragma unroll
                for (int ks = 0; ks < 4; ++ks) { const bf16x8 af = *(const LAS bf16x8*)(vt + (16 * mt + pr) * VTS + 32 * ks + 8 * dq); acc = __builtin_amdgcn_mfma_f32_16x16x32_bf16(af, bw[ks], acc, 0, 0, 0); }
                const unsigned long long u4 = *(const unsigned long long*)(U + row * AW + h * 64 + 16 * mt + 4 * dq);
#pragma unroll
                for (int r = 0; r < 4; ++r) { const float uv = __builtin_bit_cast(float, (unsigned)((u4 >> (16 * r)) & 0xffffull) << 16); const float o = uv * (acc[r] + bias); av[h][mt][r] = o; ss += o * o; }
            }
        }
        ss += __shfl_xor(ss, 16); ss += __shfl_xor(ss, 32);
        const f32x4 s0 = *(const f32x4*)(SSB + row * 8), s1 = *(const f32x4*)(SSB + row * 8 + 4);
        const float rstd_b = rsqrtf(((s0[0] + s0[1]) + (s0[2] + s0[3]) + (s1[0] + s1[1]) + (s1[2] + s1[3])) * (1.0f / BW) + EPS);
        const float sc = rsqrtf(ss * (1.0f / AW) + EPS) / rstd_b;
#pragma unroll
        for (int h = 0; h < 8; ++h)
#pragma unroll
            for (int mt = 0; mt < 4; ++mt) {
                const unsigned long long o = (unsigned long long)pk2(av[h][mt][0] * sc, av[h][mt][1] * sc) | ((unsigned long long)pk2(av[h][mt][2] * sc, av[h][mt][3] * sc) << 32);
                *(unsigned long long*)(A2 + row * DM + h * 64 + 16 * mt + 4 * dq) = o;
            }
    }
    __syncthreads();
}
__device__ __forceinline__ void p5_router(Frame& F, const Args& a) {
    unsigned char* ws = a.ws; const float* X1 = a.out; const float* gf = a.in[11]; const float* wr = a.in[12];
    float* AFF = (float*)(ws + WS_AFF); float* RS2 = (float*)(ws + WS_RS2);
    const int gw = F.vcu * NWAVES + F.wave, NGW = F.G * NWAVES, lane = F.lane;
    for (int row = gw; row < T; row += NGW) {
        float lg[16]; float ss = 0.f;
#pragma unroll
        for (int e = 0; e < 16; ++e) lg[e] = 0.f;
#pragma unroll
        for (int i = 0; i < 16; ++i) { const int c = i * 64 + lane; const float xv = X1[(size_t)row * DM + c]; ss += xv * xv; const float hv = xv * gf[c];
            const f32x4 w0 = *(const f32x4*)(wr + c * 16), w1 = *(const f32x4*)(wr + c * 16 + 4), w2 = *(const f32x4*)(wr + c * 16 + 8), w3 = *(const f32x4*)(wr + c * 16 + 12);
#pragma unroll
            for (int e = 0; e < 4; ++e) { lg[e] += hv * w0[e]; lg[4 + e] += hv * w1[e]; lg[8 + e] += hv * w2[e]; lg[12 + e] += hv * w3[e]; } }
#pragma unroll
        for (int o = 1; o < 64; o <<= 1) ss += __shfl_xor(ss, o);
        const float rstd = rsqrtf(ss * (1.0f / DM) + EPS);
        float mx = -1e30f;
#pragma unroll
        for (int e = 0; e < 16; ++e) {
#pragma unroll
            for (int o = 1; o < 64; o <<= 1) lg[e] += __shfl_xor(lg[e], o);
            lg[e] *= rstd; mx = fmaxf(mx, lg[e]); }
        float den = 0.f;
#pragma unroll
        for (int e = 0; e < 16; ++e) { lg[e] = expf(lg[e] - mx); den += lg[e]; }
        const float id = 1.0f / den;
        float mine = 0.f;
#pragma unroll
        for (int e = 0; e < 16; ++e) if (lane == e) mine = lg[e] * id;
        const int b = row / SEQ, sq = row % SEQ;
        if (lane < 16) AFF[((size_t)b * NE + lane) * SEQ + sq] = mine;
        if (lane == 0) RS2[row] = rstd;
    }
}
__device__ __forceinline__ void p6_topk(Frame& F, const Args& a) {
    unsigned char* ws = a.ws; const float* AFF = (const float*)(ws + WS_AFF);
    int* IDX = (int*)(ws + WS_IDX); float* GSEL = (float*)(ws + WS_GSEL); int* INV = (int*)(ws + WS_INV);
    const int lane = F.lane;
    if (F.wave != 0) return;
    for (int be = F.vcu; be < BATCH * NE; be += F.G) {
        const int b = be / NE, e = be % NE;
        unsigned v[32];
#pragma unroll
        for (int i = 0; i < 32; ++i) v[i] = __builtin_bit_cast(unsigned, AFF[(size_t)be * SEQ + i * 64 + lane]);
        unsigned thr = 0u;
        for (int bit = 30; bit >= 0; --bit) {
            const unsigned cand = thr | (1u << bit); int c = 0;
#pragma unroll
            for (int i = 0; i < 32; ++i) c += (v[i] >= cand) ? 1 : 0;
#pragma unroll
            for (int o = 1; o < 64; o <<= 1) c += __shfl_xor(c, o);
            if (c >= CAP) thr = cand;
        }
        int cg = 0;
#pragma unroll
        for (int i = 0; i < 32; ++i) cg += (v[i] > thr) ? 1 : 0;
#pragma unroll
        for (int o = 1; o < 64; o <<= 1) cg += __shfl_xor(cg, o);
        const int need = CAP - cg;
        int base = 0, tbase = 0;
        const unsigned long long lt = (1ull << lane) - 1ull;
#pragma unroll
        for (int i = 0; i < 32; ++i) {
            const bool gt = v[i] > thr, eq = v[i] == thr;
            const unsigned long long meq = __ballot(eq);
            const int trank = tbase + __popcll(meq & lt);
            const bool sel = gt || (eq && trank < need);
            const unsigned long long ms = __ballot(sel);
            if (sel) { const int slot = base + __popcll(ms & lt), tok = b * SEQ + i * 64 + lane;
                IDX[be * CAP + slot] = tok; GSEL[be * CAP + slot] = __builtin_bit_cast(float, v[i]); INV[(size_t)tok * NE + e] = slot; }
            base += __popcll(ms); tbase += __popcll(meq);
        }
    }
}
__device__ __forceinline__ void p9_final(Frame& F, const Args& a) {
    unsigned char* ws = a.ws; float* X1 = a.out; const bf16* Y = (const bf16*)(ws + WS_Y); const int* INV = (const int*)(ws + WS_INV); const float* gfin = a.in[16];
    const int gw = F.vcu * NWAVES + F.wave, NGW = F.G * NWAVES, lane = F.lane;
    f32x4 gv[4];
#pragma unroll
    for (int j = 0; j < 4; ++j) gv[j] = *(const f32x4*)(gfin + 256 * j + 4 * lane);
    for (int row = gw; row < T; row += NGW) {
        const int b = row / SEQ;
        const int cmine = (lane < NE) ? INV[(size_t)row * NE + lane] : -1;
        f32x4 v[4];
#pragma unroll
        for (int j = 0; j < 4; ++j) v[j] = *(const f32x4*)(X1 + (size_t)row * DM + 256 * j + 4 * lane);
        unsigned long long m = __ballot(cmine >= 0);
        while (m) {
            const int e = __builtin_ctzll(m); m &= m - 1ull;
            const int c = __builtin_amdgcn_readlane(cmine, e);
            const bf16* yr = Y + ((size_t)(b * NE + e) * CAP + c) * DM;
#pragma unroll
            for (int j = 0; j < 4; ++j) { const unsigned long long y4 = *(const unsigned long long*)(yr + 256 * j + 4 * lane);
                v[j][0] += __builtin_bit_cast(float, (unsigned)(y4 & 0xffffull) << 16); v[j][1] += __builtin_bit_cast(float, (unsigned)((y4 >> 16) & 0xffffull) << 16);
                v[j][2] += __builtin_bit_cast(float, (unsigned)((y4 >> 32) & 0xffffull) << 16); v[j][3] += __builtin_bit_cast(float, (unsigned)(y4 >> 48) << 16); }
        }
        float ss = 0.f;
#pragma unroll
        for (int j = 0; j < 4; ++j) ss += (v[j][0] * v[j][0] + v[j][1] * v[j][1]) + (v[j][2] * v[j][2] + v[j][3] * v[j][3]);
#pragma unroll
        for (int o = 1; o < 64; o <<= 1) ss += __shfl_xor(ss, o);
        const float rstd = rsqrtf(ss * (1.0f / DM) + EPS);
#pragma unroll
        for (int j = 0; j < 4; ++j) *(f32x4*)(X1 + (size_t)row * DM + 256 * j + 4 * lane) = v[j] * rstd * gv[j];
    }
}

__global__ void __launch_bounds__(NWAVES * 64, 2) mk_fwd(Args args) {
    extern __shared__ __attribute__((aligned(16))) unsigned char lds[];
    Frame F;
    F.lds = (LAS unsigned char*)lds;
    F.MISC = (volatile LAS unsigned*)(F.lds + MISC_OFF);
    F.tid = threadIdx.x; F.lane = F.tid & 63; F.wave = __builtin_amdgcn_readfirstlane(F.tid >> 6);
    F.G = gridDim.x; { const int bx = blockIdx.x; F.vcu = (F.G % 8 == 0) ? (bx % 8) * (F.G / 8) + bx / 8 : bx; }
    unsigned char* ws = args.ws;
    F.ctl = (gu32*)(ws + WS_CTL);
    for (int u = F.tid; u < (LDS_BYTES - LDSCTL_OFF) / 4; u += NWAVES * 64) ((LAS unsigned*)(F.lds + LDSCTL_OFF))[u] = 0u;
    __syncthreads();
    const int lo = args.ph_lo, hi = args.ph_hi;
    XcdBarrier bar; bar.bar = (unsigned*)(F.ctl + CW_BAR) + args.li * XCD_BAR_WORDS; bar.x = 0; bar.st = nullptr;
    if (hi - lo > 1) bar = xcd_barrier_post((unsigned*)(F.ctl + CW_BAR) + args.li * XCD_BAR_WORDS, F.MISC + 8);
#define IN(k) (lo <= (k) && (k) < hi)
#define SEAM(k) do { if (IN(k) && IN((k) + 1)) xcd_barrier(bar); } while (0)

    bf16* XN = (bf16*)(ws + WS_XN); bf16* U = (bf16*)(ws + WS_U); bf16* VG = (bf16*)(ws + WS_VG); bf16* Q = (bf16*)(ws + WS_Q); bf16* Kb = (bf16*)(ws + WS_K); bf16* Vb = (bf16*)(ws + WS_V);
    bf16* Win_t = (bf16*)(ws + WS_WIN);
    float* cosT = (float*)(ws + WS_ROPE); float* sinT = cosT + 1024;

    if (IN(0)) { p0_prologue(F, args); SEAM(0); }
    if (IN(1)) {
        pg8::Prob<false> g{XN, Win_t, nullptr, DM, 0}; pg8::StaticOrder S; S.init(T, INW, F.G, (int)blockIdx.x);
        EpiInProj E{U, VG, Q, Kb, Vb, args.in[3], args.in[6], args.in[7], cosT, sinT};
        pg8::gemm_phase<EpiInProj, pg8::Prob<false>, pg8::StaticOrder, true>(F.lds + RING_OFF, g, S, E);
        SEAM(1);
    }
    bf16* A2 = (bf16*)(ws + WS_A2); float* SSB = (float*)(ws + WS_SSB);
    if (IN(2)) {
        static_assert(attn_body::ATTN_LDS_BYTES <= RING_BYTES, "attention LDS");
        const attn_body::AttnTensors AT{(const attn_body::bf16*)Q, (const attn_body::bf16*)Kb, (const attn_body::bf16*)Vb, (attn_body::bf16*)A2, SSB};
        const attn_body::StaticOrder S((int)F.G, F.vcu);
        attn_body::attn_phase<attn_body::StaticOrder>((char*)lds + RING_OFF, AT, S);
        SEAM(2);
    }
    if (IN(3)) { p3_gmlp(F, args); SEAM(3); }
    if (IN(4)) {
        pg8::Prob<false> g{A2, (bf16*)(ws + WS_WOUT), nullptr, DM, 0}; pg8::StaticOrder S; S.init(T, DM, F.G, (int)blockIdx.x);
        EpiOutProj E{args.in[0], SSB, args.out, (bf16*)(ws + WS_X1B)};
        pg8::gemm_phase<EpiOutProj, pg8::Prob<false>, pg8::StaticOrder, true>(F.lds + RING_OFF, g, S, E);
        SEAM(4);
    }
    if (IN(5)) { p5_router(F, args); SEAM(5); }
    if (IN(6)) { p6_topk(F, args); SEAM(6); }
    int* IDX = (int*)(ws + WS_IDX); float* GSEL = (float*)(ws + WS_GSEL); float* RS2 = (float*)(ws + WS_RS2); bf16* HH = (bf16*)(ws + WS_HH); bf16* Y = (bf16*)(ws + WS_Y);
    if (IN(7)) {
        pg8::Prob<true> g{(bf16*)(ws + WS_X1B), (bf16*)(ws + WS_WGU), IDX, DM, (size_t)2048 * DM}; pg8::MoeOrder S{F.vcu, F.G, 8};
        EpiGateUp E{IDX, RS2, HH};
        pg8::gemm_phase<EpiGateUp, pg8::Prob<true>, pg8::MoeOrder, true>(F.lds + RING_OFF, g, S, E);
        SEAM(7);
    }
    if (IN(8)) {
        pg8::Prob<false> g{HH, (bf16*)(ws + WS_WD), nullptr, EFF, (size_t)DM * EFF}; pg8::MoeOrder S{F.vcu, F.G, 4};
        EpiDown E{GSEL, Y};
        pg8::gemm_phase<EpiDown, pg8::Prob<false>, pg8::MoeOrder, true>(F.lds + RING_OFF, g, S, E);
        SEAM(8);
    }
    if (IN(9)) { p9_final(F, args); }
#undef IN
#undef SEAM
}
__global__ void nv_rope_table(float* rope) {
    const int t = blockIdx.x * blockDim.x + threadIdx.x;
    if (t >= 64 * 16) return;
    const int pos = t / 16, i = t % 16;
    const float inv = powf(10000.0f, -(float)i / 16.0f);
    const float ang = (float)pos * inv;
    rope[2 * t] = cosf(ang); rope[2 * t + 1] = sinf(ang);
}
__global__ void nv_fill_i32(int* p, int v, int n) { const int i = blockIdx.x * blockDim.x + threadIdx.x; if (i < n) p[i] = v; }

__global__ void __launch_bounds__(256) nv_xn(const float* __restrict__ x, bf16* __restrict__ xn) {
    const int row = blockIdx.x * 4 + (threadIdx.x >> 6), lane = threadIdx.x & 63;
    const float* xr = x + (size_t)row * DM;
    float v[16]; float ss = 0.f;
#pragma unroll
    for (int i = 0; i < 16; ++i) { v[i] = xr[i * 64 + lane]; ss += v[i] * v[i]; }
    ss = wave_sum(ss);
    const float rstd = rsqrtf(ss * (1.0f / DM) + EPS);
#pragma unroll
    for (int i = 0; i < 16; ++i) xn[(size_t)row * DM + i * 64 + lane] = (bf16)f2bf(v[i] * rstd);
}

template <int NB, class AL, class BL, class EP>
__global__ void __launch_bounds__(256) nv_gemm(AL al, BL bl, EP ep, int K) {
    __shared__ float As[16][68];
    __shared__ float Bs[NB][16][68];
    __shared__ float Ct[NB][64][65];
    const int tid = threadIdx.x, ty = tid >> 4, tx = tid & 15;
    const int row0 = blockIdx.y * 64, col0 = blockIdx.x * 64;
    float acc[NB][4][4];
#pragma unroll
    for (int b = 0; b < NB; ++b)
#pragma unroll
        for (int i = 0; i < 4; ++i)
#pragma unroll
            for (int j = 0; j < 4; ++j) acc[b][i][j] = 0.f;
    for (int k0 = 0; k0 < K; k0 += 16) {
#pragma unroll
        for (int i = 0; i < 4; ++i) { const int e = tid + i * 256, r = e >> 4, kk = e & 15; As[kk][r] = al(row0 + r, k0 + kk); }
#pragma unroll
        for (int b = 0; b < NB; ++b)
#pragma unroll
            for (int i = 0; i < 4; ++i) { const int e = tid + i * 256, kk = e >> 6, c = e & 63; Bs[b][kk][c] = bl(b, k0 + kk, col0 + c, row0); }
        __syncthreads();
#pragma unroll
        for (int kk = 0; kk < 16; ++kk) {
            float a[4];
#pragma unroll
            for (int i = 0; i < 4; ++i) a[i] = As[kk][ty * 4 + i];
#pragma unroll
            for (int b = 0; b < NB; ++b) {
                float bv[4];
#pragma unroll
                for (int j = 0; j < 4; ++j) bv[j] = Bs[b][kk][tx * 4 + j];
#pragma unroll
                for (int i = 0; i < 4; ++i)
#pragma unroll
                    for (int j = 0; j < 4; ++j) acc[b][i][j] += a[i] * bv[j];
            }
        }
        __syncthreads();
    }
#pragma unroll
    for (int b = 0; b < NB; ++b)
#pragma unroll
        for (int i = 0; i < 4; ++i)
#pragma unroll
            for (int j = 0; j < 4; ++j) Ct[b][ty * 4 + i][tx * 4 + j] = acc[b][i][j];
    __syncthreads();
    ep(Ct, row0, col0, tid);
}

struct AL_bf16 { const bf16* A; int lda; int pad; __device__ float operator()(int r, int k) const { return bf2f(A[(size_t)r * lda + k]); } };
struct BL_win { const float* w; const float* g; __device__ float operator()(int, int k, int c, int) const { return w[(size_t)k * INW + c] * g[k]; } };
struct EP_inproj {
    bf16 *U, *VG, *Q, *Kb, *Vb; const float *gv, *gq, *gk;
    __device__ void operator()(float (*Ct)[64][65], int row0, int col0, int tid) const {
        const int ct = col0 / 64;
        const int r = tid >> 2, seg = tid & 3;
        const int row = row0 + r;
        float v[16];
#pragma unroll
        for (int j = 0; j < 16; ++j) v[j] = Ct[0][r][seg * 16 + j];
        if (ct < 8) {
#pragma unroll
            for (int j = 0; j < 16; ++j) U[(size_t)row * AW + ct * 64 + seg * 16 + j] = (bf16)f2bf(gelu_tanh(v[j]));
        } else if (ct < 16) {
            const int h = ct - 8; float ss = 0.f;
#pragma unroll
            for (int j = 0; j < 16; ++j) { v[j] = gelu_tanh(v[j]); ss += v[j] * v[j]; }
            ss += __shfl_xor(ss, 1); ss += __shfl_xor(ss, 2);
            const float rstd = rsqrtf(ss * (1.0f / 64.0f) + EPS);
#pragma unroll
            for (int j = 0; j < 16; ++j) VG[(size_t)row * AW + h * 64 + seg * 16 + j] = (bf16)f2bf(v[j] * rstd * gv[h * 64 + seg * 16 + j]);
        } else if (ct < 26) {
            const bool isq = ct < 24; const int h = isq ? ct - 16 : ct - 24; const float* g = isq ? gq : gk;
            float ss = 0.f;
#pragma unroll
            for (int j = 0; j < 16; ++j) ss += v[j] * v[j];
            ss += __shfl_xor(ss, 1); ss += __shfl_xor(ss, 2);
            const float rstd = rsqrtf(ss * (1.0f / 64.0f) + EPS);
            const int t = row % SEQ; const int pos = (seg < 2) ? (t / 64) : (t % 64);
#pragma unroll
            for (int j = 0; j < 16; ++j) {
                const int d = seg * 16 + j, pd = (seg ^ 1) * 16 + j;
                const float me = v[j] * rstd * g[d], pa = Ct[0][r][pd] * rstd * g[pd];
                const float inv = powf(10000.0f, -(float)j / 16.0f), ang = (float)pos * inv;
                const float c = cosf(ang), s = sinf(ang);
                const float o = (seg & 1) ? (me * c + pa * s) : (me * c - pa * s);
                if (isq) Q[(size_t)row * BW + h * 64 + d] = (bf16)f2bf(o * QSCALE);
                else Kb[(size_t)row * KVW + h * 64 + d] = (bf16)f2bf(o);
            }
        } else {
            const int h = ct - 26;
#pragma unroll
            for (int j = 0; j < 16; ++j) Vb[(size_t)row * KVW + h * 64 + seg * 16 + j] = (bf16)f2bf(v[j]);
        }
    }
};

__global__ void __launch_bounds__(256) nv_attn(const bf16* __restrict__ Q, const bf16* __restrict__ Kb, const bf16* __restrict__ Vb, bf16* __restrict__ A2, float* __restrict__ SSB) {
    __shared__ float Ks[64][64];
    __shared__ float Vs[64][64];
    const int tid = threadIdx.x, qb = blockIdx.x, hq = blockIdx.y, b = blockIdx.z, hk = hq >> 2;
    const size_t row = (size_t)b * SEQ + qb * 256 + tid;
    float q[64], o[64];
#pragma unroll
    for (int d = 0; d < 64; ++d) { q[d] = bf2f(Q[row * BW + hq * 64 + d]); o[d] = 0.f; }
    float m = -1e30f, l = 0.f;
    for (int kt = 0; kt < SEQ / 64; ++kt) {
        __syncthreads();
#pragma unroll
        for (int i = 0; i < 16; ++i) { const int e = tid + i * 256, key = e >> 6, d = e & 63; const size_t kr = (size_t)b * SEQ + kt * 64 + key;
            Ks[key][d] = bf2f(Kb[kr * KVW + hk * 64 + d]); Vs[key][d] = bf2f(Vb[kr * KVW + hk * 64 + d]); }
        __syncthreads();
        for (int key = 0; key < 64; ++key) {
            float s = 0.f;
#pragma unroll
            for (int d = 0; d < 64; ++d) s += q[d] * Ks[key][d];
            const float mn = fmaxf(m, s), corr = exp2f(m - mn), p = exp2f(s - mn);
            l = l * corr + p; m = mn;
#pragma unroll
            for (int d = 0; d < 64; ++d) o[d] = o[d] * corr + p * Vs[key][d];
        }
    }
    const float il = 1.0f / l; float ss = 0.f;
#pragma unroll
    for (int d = 0; d < 64; ++d) { const float ov = o[d] * il; ss += ov * ov; A2[row * DM + 512 + hq * 64 + d] = (bf16)f2bf(ov); }
    SSB[row * 8 + hq] = ss;
}

__global__ void __launch_bounds__(512) nv_gmlp(const bf16* __restrict__ U, const bf16* __restrict__ VG, const float* __restrict__ ws, const float* __restrict__ bs, const float* __restrict__ SSB, bf16* __restrict__ A2) {
    __shared__ float red[8];
    const int tid = threadIdx.x, h = tid >> 6, d = tid & 63;
    const int row = blockIdx.x, b = row / SEQ, s = row % SEQ, ch = s / CHUNK, p = s % CHUNK;
    const size_t base = (size_t)b * SEQ + ch * CHUNK;
    float gate = bs[h * CHUNK + p];
    const float* wr = ws + ((size_t)h * CHUNK + p) * CHUNK;
    for (int q = 0; q < CHUNK; ++q) gate += wr[q] * bf2f(VG[(base + q) * AW + h * 64 + d]);
    const float a = bf2f(U[(size_t)row * AW + tid]) * gate;
    float ss = wave_sum(a * a);
    if ((tid & 63) == 0) red[h] = ss;
    __syncthreads();
    float tot = 0.f, sb = 0.f;
#pragma unroll
    for (int i = 0; i < 8; ++i) { tot += red[i]; sb += SSB[(size_t)row * 8 + i]; }
    const float rstd_a = rsqrtf(tot * (1.0f / AW) + EPS), rstd_b = rsqrtf(sb * (1.0f / BW) + EPS);
    A2[(size_t)row * DM + tid] = (bf16)f2bf(a * rstd_a / rstd_b);
}

struct BL_wout { const float* w; const float* ga; const float* gb; __device__ float operator()(int, int k, int c, int) const { return w[(size_t)k * DM + c] * (k < 512 ? ga[k] : gb[k - 512]); } };
struct EP_outproj {
    const float* x; const float* SSB; float* X1; bf16* X1B;
    __device__ void operator()(float (*Ct)[64][65], int row0, int col0, int tid) const {
        const int r = tid >> 2, seg = tid & 3; const size_t row = row0 + r;
        float sb = 0.f;
#pragma unroll
        for (int i = 0; i < 8; ++i) sb += SSB[row * 8 + i];
        const float rstd_b = rsqrtf(sb * (1.0f / BW) + EPS);
#pragma unroll
        for (int j = 0; j < 16; ++j) { const int c = col0 + seg * 16 + j; const float v = x[row * DM + c] + rstd_b * Ct[0][r][seg * 16 + j]; X1[row * DM + c] = v; X1B[row * DM + c] = (bf16)f2bf(v); }
    }
};

__global__ void __launch_bounds__(256) nv_router(const float* __restrict__ X1, const float* __restrict__ gf, const float* __restrict__ wr, float* __restrict__ AFF, float* __restrict__ RS2) {
    const int row = blockIdx.x * 4 + (threadIdx.x >> 6), lane = threadIdx.x & 63;
    float lg[16]; float ss = 0.f;
#pragma unroll
    for (int e = 0; e < 16; ++e) lg[e] = 0.f;
#pragma unroll
    for (int i = 0; i < 16; ++i) { const int c = i * 64 + lane; const float xv = X1[(size_t)row * DM + c]; ss += xv * xv; const float hv = xv * gf[c];
#pragma unroll
        for (int e = 0; e < 16; ++e) lg[e] += hv * wr[c * 16 + e]; }
    ss = wave_sum(ss);
    const float rstd = rsqrtf(ss * (1.0f / DM) + EPS);
    float mx = -1e30f;
#pragma unroll
    for (int e = 0; e < 16; ++e) { lg[e] = wave_sum(lg[e]) * rstd; mx = fmaxf(mx, lg[e]); }
    float den = 0.f;
#pragma unroll
    for (int e = 0; e < 16; ++e) { lg[e] = expf(lg[e] - mx); den += lg[e]; }
    const float id = 1.0f / den;
    const int b = row / SEQ, s = row % SEQ;
    float mine = 0.f;
#pragma unroll
    for (int e = 0; e < 16; ++e) if (lane == e) mine = lg[e] * id;
    if (lane < 16) AFF[((size_t)b * NE + lane) * SEQ + s] = mine;
    if (lane == 0) RS2[row] = rstd;
}

__global__ void __launch_bounds__(512) nv_topk(const float* __restrict__ AFF, int* __restrict__ IDX, float* __restrict__ GSEL, int* __restrict__ INV) {
    __shared__ float av[SEQ];
    const int be = blockIdx.x, b = be / NE, e = be % NE, tid = threadIdx.x;
#pragma unroll
    for (int i = 0; i < 4; ++i) av[tid + i * 512] = AFF[(size_t)be * SEQ + tid + i * 512];
    __syncthreads();
#pragma unroll
    for (int i = 0; i < 4; ++i) {
        const int s = tid + i * 512; const float v = av[s]; int rank = 0;
        for (int j = 0; j < SEQ; ++j) { const float w = av[j]; rank += (w > v || (w == v && j < s)) ? 1 : 0; }
        if (rank < CAP) { IDX[be * CAP + rank] = b * SEQ + s; GSEL[be * CAP + rank] = v; INV[((size_t)b * SEQ + s) * NE + e] = rank; }
    }
}

struct AL_gather { const bf16* A; const int* idx; __device__ float operator()(int r, int k) const { return bf2f(A[(size_t)idx[r] * DM + k]); } };
struct BL_gu { const float* wg; const float* wu; const float* g; __device__ float operator()(int b, int k, int c, int row0) const { const int e = (row0 / CAP) % NE; const float* w = b ? wu : wg; return w[((size_t)e * DM + k) * EFF + c] * g[k]; } };
struct EP_gu {
    const int* idx; const float* RS2; bf16* HH;
    __device__ void operator()(float (*Ct)[64][65], int row0, int col0, int tid) const {
        const int r = tid >> 2, seg = tid & 3; const size_t row = row0 + r; const float rs = RS2[idx[row]];
#pragma unroll
        for (int j = 0; j < 16; ++j) { const float a = Ct[0][r][seg * 16 + j] * rs, bb = Ct[1][r][seg * 16 + j] * rs; const float hv = a / (1.0f + expf(-a)) * bb; HH[row * EFF + col0 + seg * 16 + j] = (bf16)f2bf(hv); }
    }
};
struct BL_down { const float* wd; __device__ float operator()(int, int k, int c, int row0) const { const int e = (row0 / CAP) % NE; return wd[((size_t)e * EFF + k) * DM + c]; } };
struct EP_down {
    const float* GSEL; bf16* Y;
    __device__ void operator()(float (*Ct)[64][65], int row0, int col0, int tid) const {
        const int r = tid >> 2, seg = tid & 3; const size_t row = row0 + r; const float g = GSEL[row];
#pragma unroll
        for (int j = 0; j < 16; ++j) Y[row * DM + col0 + seg * 16 + j] = (bf16)f2bf(Ct[0][r][seg * 16 + j] * g);
    }
};

__global__ void __launch_bounds__(256) nv_final(float* __restrict__ X1out, const bf16* __restrict__ Y, const int* __restrict__ INV, const float* __restrict__ gfin) {
    const int row = blockIdx.x * 4 + (threadIdx.x >> 6), lane = threadIdx.x & 63, b = row / SEQ;
    float v[16];
#pragma unroll
    for (int i = 0; i < 16; ++i) v[i] = X1out[(size_t)row * DM + i * 64 + lane];
    for (int e = 0; e < NE; ++e) {
        const int c = INV[(size_t)row * NE + e];
        if (c >= 0) { const bf16* yr = Y + ((size_t)(b * NE + e) * CAP + c) * DM;
#pragma unroll
            for (int i = 0; i < 16; ++i) v[i] += bf2f(yr[i * 64 + lane]); }
    }
    float ss = 0.f;
#pragma unroll
    for (int i = 0; i < 16; ++i) ss += v[i] * v[i];
    ss = wave_sum(ss);
    const float rstd = rsqrtf(ss * (1.0f / DM) + EPS);
#pragma unroll
    for (int i = 0; i < 16; ++i) X1out[(size_t)row * DM + i * 64 + lane] = v[i] * rstd * gfin[i * 64 + lane];
}

#ifndef HYBRID
#define HYBRID 0
#endif
static int g_grid = 0;
static void launch_mk(const Args& base, int lo, int hi, int li, hipStream_t stream) {
    Args a = base; a.ph_lo = lo; a.ph_hi = hi; a.li = li; a.pad = 0;
    void* params[] = {(void*)&a};
    hipError_t e = hipLaunchCooperativeKernel((const void*)mk_fwd, dim3(g_grid), dim3(NWAVES * 64), params, LDS_BYTES, stream);
    if (e != hipSuccess) fprintf(stderr, "kernel_launch: cooperative launch failed: %s (grid %d)\n", hipGetErrorString(e), g_grid);
}
extern "C" void kernel_launch(void* const* d_in, const int* in_sizes, int n_in, void* d_out, int out_size, void* d_ws, size_t ws_size, hipStream_t stream) {
    if (n_in != 17 || in_sizes[0] != T * DM || out_size != T * DM || ws_size < WS_END) { fprintf(stderr, "kernel_launch: unexpected shapes / workspace (%d inputs, ws %zu)\n", n_in, ws_size); return; }
    if (g_grid == 0) {
        int dev = 0, cus = 0, per_cu = 0;
        if (hipGetDevice(&dev) != hipSuccess || hipDeviceGetAttribute(&cus, hipDeviceAttributeMultiprocessorCount, dev) != hipSuccess) { g_grid = -1; return; }
        if (hipFuncSetAttribute((const void*)mk_fwd, hipFuncAttributeMaxDynamicSharedMemorySize, LDS_BYTES) != hipSuccess) { fprintf(stderr, "kernel_launch: hipFuncSetAttribute failed\n"); g_grid = -1; return; }
        if (hipOccupancyMaxActiveBlocksPerMultiprocessor(&per_cu, (const void*)mk_fwd, NWAVES * 64, LDS_BYTES) != hipSuccess || per_cu < 1) { fprintf(stderr, "kernel_launch: occupancy query says %d blocks per CU\n", per_cu); per_cu = 1; }
        (void)hipGetLastError();
        if (per_cu > 1) per_cu = 1;
        g_grid = cus * per_cu;
    }
    if (g_grid < 0) return;
    const float* x = (const float*)d_in[0]; const float* g_mix = (const float*)d_in[1]; const float* w_in = (const float*)d_in[2];
    const float* g_v = (const float*)d_in[3]; const float* w_s = (const float*)d_in[4]; const float* b_s = (const float*)d_in[5];
    const float* g_q = (const float*)d_in[6]; const float* g_k = (const float*)d_in[7]; const float* g_a = (const float*)d_in[8]; const float* g_b = (const float*)d_in[9];
    const float* w_out = (const float*)d_in[10]; const float* g_ffn = (const float*)d_in[11]; const float* w_router = (const float*)d_in[12];
    const float* w_gate = (const float*)d_in[13]; const float* w_up = (const float*)d_in[14]; const float* w_down = (const float*)d_in[15]; const float* g_fin = (const float*)d_in[16];
    unsigned char* ws = (unsigned char*)d_ws; float* out = (float*)d_out;
    float* SSB = (float*)(ws + WS_SSB); float* RS2 = (float*)(ws + WS_RS2); float* AFF = (float*)(ws + WS_AFF);
    int* IDX = (int*)(ws + WS_IDX); float* GSEL = (float*)(ws + WS_GSEL); int* INV = (int*)(ws + WS_INV);
    bf16* X1B = (bf16*)(ws + WS_X1B); bf16* XN = (bf16*)(ws + WS_XN); bf16* U = (bf16*)(ws + WS_U); bf16* VG = (bf16*)(ws + WS_VG);
    bf16* Q = (bf16*)(ws + WS_Q); bf16* Kb = (bf16*)(ws + WS_K); bf16* Vb = (bf16*)(ws + WS_V); bf16* A2 = (bf16*)(ws + WS_A2);
    bf16* HH = (bf16*)(ws + WS_HH); bf16* Y = (bf16*)(ws + WS_Y);
    (void)x; (void)g_mix; (void)w_in; (void)g_v; (void)g_q; (void)g_k; (void)XN; (void)INV;

    (void)hipMemsetAsync((char*)d_ws + WS_CTL, 0, 1 * MiB, stream);
    Args a{};
    for (int i = 0; i < 17; ++i) a.in[i] = (const float*)d_in[i];
    a.out = out; a.ws = ws;
#if HYBRID
    launch_mk(a, 0, 3, 0, stream);
    launch_mk(a, 3, 4, 1, stream);
    launch_mk(a, 4, 5, 1, stream);
    launch_mk(a, 5, 6, 1, stream);
    launch_mk(a, 6, 7, 1, stream);
    launch_mk(a, 7, 9, 2, stream);
    launch_mk(a, 9, 10, 3, stream);
#else
    launch_mk(a, 0, N_PHASES, 0, stream);
#endif
}
```

```cpp
#include <hip/hip_runtime.h>
#include <hip/hip_bf16.h>
#include <cstdint>
#include <cstdio>

constexpr int BATCH = 16, SEQ = 2048, DM = 1024, T = BATCH * SEQ;
constexpr int HD = 64, AH = 8, AW = 512, CHUNK = 128, BH = 8, BKV = 2, BW = 512, KVW = 128, INW = 1792;
constexpr int NE = 16, CAP = 256, EFF = 1024, NSLOT = BATCH * NE * CAP;
constexpr float EPS = 1e-6f;
constexpr float QSCALE = 0.125f * 1.4426950408889634f;

typedef unsigned short bf16;

constexpr size_t MiB = 1u << 20;
constexpr size_t WS_CTL = 0;
constexpr size_t WS_SSB = 1 * MiB;
constexpr size_t WS_RS2 = 2 * MiB;
constexpr size_t WS_AFF = 3 * MiB;
constexpr size_t WS_IDX = 5 * MiB;
constexpr size_t WS_GSEL = 6 * MiB;
constexpr size_t WS_INV = 7 * MiB;
constexpr size_t WS_ROPE = 9 * MiB;
constexpr size_t WS_WIN = 16 * MiB;
constexpr size_t WS_WOUT = 20 * MiB;
constexpr size_t WS_WS = 22 * MiB;
constexpr size_t WS_WGU = 24 * MiB;
constexpr size_t WS_WD = 88 * MiB;
constexpr size_t WS_X1B = 120 * MiB;
constexpr size_t WS_XN = 184 * MiB;
constexpr size_t WS_U = 248 * MiB;
constexpr size_t WS_VG = 280 * MiB;
constexpr size_t WS_Q = 312 * MiB;
constexpr size_t WS_K = 344 * MiB;
constexpr size_t WS_V = 352 * MiB;
constexpr size_t WS_A2 = 360 * MiB;
constexpr size_t WS_HH = 184 * MiB;
constexpr size_t WS_Y = 312 * MiB;
constexpr size_t WS_END = 440 * MiB;

__device__ __forceinline__ unsigned f2bf(float f) { unsigned u = __builtin_bit_cast(unsigned, f); return (u + 0x7fffu + ((u >> 16) & 1u)) >> 16; }
__device__ __forceinline__ float bf2f(bf16 h) { return __builtin_bit_cast(float, (unsigned)h << 16); }
__device__ __forceinline__ float gelu_tanh(float x) { return 0.5f * x * (1.0f + tanhf(0.7978845608028654f * (x + 0.044715f * x * x * x))); }
__device__ __forceinline__ float wave_sum(float v) {
#pragma unroll
    for (int o = 1; o < 64; o <<= 1) v += __shfl_xor(v, o);
    return v;
}

namespace pg8 {
#define PG8_LAS __attribute__((address_space(3)))
typedef unsigned short bf16_t;
typedef short bf16x8 __attribute__((ext_vector_type(8)));
typedef float f32x4 __attribute__((ext_vector_type(4)));
typedef unsigned u32x4 __attribute__((ext_vector_type(4)));
typedef unsigned u32x2 __attribute__((ext_vector_type(2)));
constexpr int BM = 256, BK = 64, HALF = 128, HTB = HALF * BK * 2  , STAGE_BYTES = 8 * HTB, NXCD = 8, WGM = 8;

__host__ __device__ __forceinline__ int lds_byte(int r, int c) { const int st = (r >> 4) * 2 + (c >> 5), rr = r & 15, cc = c & 31, ob = rr * 64 + cc * 2; return st * 1024 + (ob ^ (((ob >> 9) & 1) << 5)); }
__host__ __device__ __forceinline__ void stage_rc(int b, int& R, int& C) { const int st = b / 1024, sb = b % 1024, swz = sb ^ (((sb >> 9) & 1) << 5); R = (st >> 1) * 16 + swz / 64; C = (st & 1) * 32 + (swz % 64) / 2; }
__host__ __device__ __forceinline__ int perm32(int rho) { const int n = rho >> 4, i = rho & 15; return 8 * (i >> 2) + 4 * n + (i & 3); }

struct Unit { int pm, pn; };

struct StaticOrder {
    int nM, nN, nwg, G, c;
    __host__ __device__ void init(int M, int N, int G_, int c_) { nM = M / BM; nN = N / BM; nwg = nM * nN; G = G_; c = c_; }
    __host__ __device__ bool next(int i, Unit& u) const {
        const long L = (long)i * G + c; if (L >= nwg) return false;
        int wgid = (int)L; { const int q = nwg / NXCD, r = nwg % NXCD, xcd = wgid % NXCD, off = wgid / NXCD; wgid = (xcd < r ? xcd * (q + 1) : r * (q + 1) + (xcd - r) * q) + off; }
        const int nig = WGM * nN, gid = wgid / nig, fm = gid * WGM, gsz = (nM - fm) < WGM ? (nM - fm) : WGM;
        u.pm = fm + ((wgid % nig) % gsz); u.pn = (wgid % nig) / gsz; return true;
    }
};
struct MoeOrder {
    int vcu, G, npn;
    __device__ bool next(int i, Unit& u) const {
        if (G == 256) { if (i >= npn) return false; const int xcd = vcu >> 5, l = vcu & 31, idx = i * 32 + l, per = 16 * npn, ei = idx / per, rem = idx % per;
            u.pm = (rem / npn) * 16 + xcd + 8 * ei; u.pn = rem % npn; return true; }
        const long L = (long)i * G + vcu; if (L >= 256L * npn) return false; u.pm = (int)(L / npn); u.pn = (int)(L % npn); return true;
    }
};

__device__ __forceinline__ unsigned cvt_pk_bf16(float lo, float hi) { unsigned r; asm volatile("v_cvt_pk_bf16_f32 %0, %1, %2" : "=v"(r) : "v"(lo), "v"(hi)); return r; }

template <bool GATHER_> struct Prob {
    static constexpr bool GATHER = GATHER_;
    const bf16_t* A; const bf16_t* Bt; const int* idx; int K; size_t estride;
    __device__ __forceinline__ const char* a_base(const Unit& u) const { return GATHER ? (const char*)A : (const char*)(A + (size_t)u.pm * BM * K); }
    __device__ __forceinline__ const char* b_base(const Unit& u) const { return (const char*)(Bt + (size_t)(u.pm & 15) * estride + (size_t)u.pn * BM * K); }
    __device__ __forceinline__ unsigned a_row(const Unit& u, int r) const { return (unsigned)idx[u.pm * BM + r]; }
};

template <class Epi, class PB, class Sched, bool ALIGN_EPI>
__device__ __forceinline__ void gemm_phase(PG8_LAS unsigned char* lds, const PB g, const Sched& S, const Epi& E) {
    const int tid = threadIdx.x, wid = __builtin_amdgcn_readfirstlane(tid >> 6), lane = tid & 63, wr = wid >> 2, wc = wid & 3, fr = lane & 15, fq = lane >> 4;
    const int K = g.K, nt = K / BK;
    unsigned voffA[2], voffB[2]; int RA[2], CA2[2];
#pragma unroll
    for (int i = 0; i < 2; ++i) { int R, C; stage_rc(tid * 16 + i * 8192, R, C); const int Rb = Epi::PERM ? ((R & ~31) + perm32(R & 31)) : R;
        voffA[i] = (unsigned)(R * K + C) * 2u; voffB[i] = (unsigned)(Rb * K + C) * 2u; RA[i] = R; CA2[i] = C * 2; }
    const size_t kstep = (size_t)(BK * 2);
    const size_t hstep = (size_t)HALF * K * 2;
    const unsigned ldsw = (unsigned)wid * 1024u;
    const int aoff = lds_byte(wr * 64 + fr, fq * 8), boff = lds_byte(wc * 32 + fr, fq * 8);
#define PG8_SA(b, h) (((b) * 2 + (h)) * HTB)
#define PG8_SB(b, h) ((4 + (b) * 2 + (h)) * HTB)
#define PG8_STAGE(bufoff, gbase, voff) do { _Pragma("unroll") for (int _i = 0; _i < 2; ++_i) \
        __builtin_amdgcn_global_load_lds((const unsigned*)((const char*)(gbase) + (voff)[_i]), (PG8_LAS unsigned*)(lds + (bufoff) + ldsw + _i * 8192), 16, 0, 0); } while (0)
#define PG8_STAGE_A(bufoff, gptr, h, VG) do { if constexpr (PB::GATHER) { PG8_STAGE(bufoff, gptr, VG[h]); } else { PG8_STAGE(bufoff, (gptr) + (h) * hstep, voffA); } } while (0)
#define PG8_LDA(dst, b, h) do { _Pragma("unroll") for (int m = 0; m < 4; ++m) _Pragma("unroll") for (int k = 0; k < 2; ++k) dst[m][k] = *(const PG8_LAS bf16x8*)(lds + PG8_SA(b, h) + aoff + m * 2048 + k * 1024); } while (0)
#define PG8_LDB(dst, b, h) do { _Pragma("unroll") for (int n = 0; n < 2; ++n) _Pragma("unroll") for (int k = 0; k < 2; ++k) dst[n][k] = *(const PG8_LAS bf16x8*)(lds + PG8_SB(b, h) + boff + n * 2048 + k * 1024); } while (0)
#define PG8_MMA(ai, bj, At, Bt) do { __builtin_amdgcn_s_setprio(1); _Pragma("unroll") for (int m = 0; m < 4; ++m) _Pragma("unroll") for (int n = 0; n < 2; ++n) _Pragma("unroll") for (int k = 0; k < 2; ++k) \
        acc[ai][bj][m][n] = __builtin_amdgcn_mfma_f32_16x16x32_bf16(Bt[n][k], At[m][k], acc[ai][bj][m][n], 0, 0, 0); __builtin_amdgcn_s_setprio(0); } while (0)
#define PG8_WAIT_V(n) asm volatile("s_waitcnt vmcnt(" #n ")" ::: "memory")
#define PG8_WAIT_L(n) asm volatile("s_waitcnt lgkmcnt(" #n ")" ::: "memory")
#define PG8_BAR __builtin_amdgcn_s_barrier()
#define PG8_SCHED __builtin_amdgcn_sched_barrier(0)
    Unit cur, nxt; int ui = 0;
    if (!S.next(0, cur)) return;
    f32x4 acc[2][2][4][2];
#pragma unroll
    for (int a = 0; a < 2; ++a)
#pragma unroll
        for (int b = 0; b < 2; ++b)
#pragma unroll
            for (int m = 0; m < 4; ++m)
#pragma unroll
                for (int n = 0; n < 2; ++n) acc[a][b][m][n] = (f32x4){0.f, 0.f, 0.f, 0.f};
    bf16x8 At[4][2], B0[2][2], B1[2][2];
    const char* cA = g.a_base(cur); const char* cB = g.b_base(cur);
    unsigned vGc[2][2], vGx[2][2];
    if constexpr (PB::GATHER) {
#pragma unroll
        for (int h = 0; h < 2; ++h)
#pragma unroll
            for (int i = 0; i < 2; ++i) { vGc[h][i] = g.a_row(cur, h * HALF + RA[i]) * (unsigned)(K * 2) + (unsigned)CA2[i]; vGx[h][i] = vGc[h][i]; }
        asm volatile("s_waitcnt vmcnt(0)" ::: "memory");
    }
    PG8_STAGE(PG8_SB(0, 0), cB, voffB); PG8_STAGE(PG8_SB(0, 1), cB + hstep, voffB); PG8_STAGE_A(PG8_SA(0, 0), cA, 0, vGc); PG8_STAGE_A(PG8_SA(0, 1), cA, 1, vGc);
    if (wr == 1) PG8_BAR;
    PG8_WAIT_V(2); PG8_BAR;
    PG8_STAGE(PG8_SB(1, 0), cB + kstep, voffB); PG8_STAGE_A(PG8_SA(1, 0), cA + kstep, 0, vGc); PG8_STAGE(PG8_SB(1, 1), cB + hstep + kstep, voffB);
    PG8_WAIT_V(6); PG8_BAR;
    for (;;) {
        const bool has_next = S.next(ui + 1, nxt);
        const char* nA = has_next ? g.a_base(nxt) : cA; const char* nB = has_next ? g.b_base(nxt) : cB;
        for (int t = 0; t < nt; t += 2) {
            const bool last = (t == nt - 2);
            const char* a1 = cA + (size_t)(t + 1) * kstep;
            const char* a2 = last ? nA : cA + (size_t)(t + 2) * kstep; const char* b2 = last ? nB : cB + (size_t)(t + 2) * kstep;
            const char* a3 = a2 + kstep; const char* b3 = b2 + kstep;
            if constexpr (PB::GATHER) {
                if (last && has_next) {
#pragma unroll
                    for (int h = 0; h < 2; ++h)
#pragma unroll
                        for (int i = 0; i < 2; ++i) vGx[h][i] = g.a_row(nxt, h * HALF + RA[i]) * (unsigned)(K * 2) + (unsigned)CA2[i];
                }
            }
            PG8_LDB(B0, 0, 0); PG8_LDB(B1, 0, 1); PG8_SCHED; PG8_LDA(At, 0, 0); PG8_STAGE_A(PG8_SA(1, 1), a1, 1, vGc);
            PG8_WAIT_V(8); PG8_WAIT_L(0); PG8_BAR; PG8_MMA(0, 0, At, B0); PG8_MMA(0, 1, At, B1); PG8_BAR; PG8_SCHED;
            PG8_LDA(At, 0, 1); PG8_STAGE(PG8_SB(0, 0), b2, voffB); PG8_STAGE(PG8_SB(0, 1), b2 + hstep, voffB); PG8_STAGE_A(PG8_SA(0, 0), a2, 0, vGx);
            PG8_WAIT_V(8); PG8_WAIT_L(0); PG8_BAR; PG8_MMA(1, 0, At, B0); PG8_MMA(1, 1, At, B1); PG8_BAR; PG8_SCHED;
            PG8_LDB(B0, 1, 0); PG8_LDB(B1, 1, 1); PG8_SCHED; PG8_LDA(At, 1, 0); PG8_STAGE_A(PG8_SA(0, 1), a2, 1, vGx);
            PG8_WAIT_V(8); PG8_WAIT_L(0); PG8_BAR; PG8_MMA(0, 0, At, B0); PG8_MMA(0, 1, At, B1); PG8_BAR; PG8_SCHED;
            PG8_LDA(At, 1, 1); PG8_STAGE(PG8_SB(1, 0), b3, voffB); PG8_STAGE(PG8_SB(1, 1), b3 + hstep, voffB); PG8_STAGE_A(PG8_SA(1, 0), a3, 0, vGx);
            PG8_WAIT_V(8); PG8_WAIT_L(0); PG8_BAR; PG8_MMA(1, 0, At, B0); PG8_MMA(1, 1, At, B1); PG8_BAR; PG8_SCHED;
        }
        if constexpr (ALIGN_EPI) { if (wr == 0) PG8_BAR; }
        E(acc, cur, wr, wc, fr, fq);
        if (!has_next) break;
#pragma unroll
        for (int a = 0; a < 2; ++a)
#pragma unroll
            for (int b = 0; b < 2; ++b)
#pragma unroll
                for (int m = 0; m < 4; ++m)
#pragma unroll
                    for (int n = 0; n < 2; ++n) acc[a][b][m][n] = (f32x4){0.f, 0.f, 0.f, 0.f};
        cur = nxt; cA = nA; cB = nB; ++ui;
        if constexpr (PB::GATHER) {
#pragma unroll
            for (int h = 0; h < 2; ++h)
#pragma unroll
                for (int i = 0; i < 2; ++i) vGc[h][i] = vGx[h][i];
        }
        if constexpr (ALIGN_EPI) { if (wr == 1) PG8_BAR; }
    }
    PG8_WAIT_V(0);
    if constexpr (!ALIGN_EPI) { if (wr == 0) PG8_BAR; }
    PG8_BAR;
#undef PG8_SA
#undef PG8_SB
#undef PG8_STAGE
#undef PG8_STAGE_A
#undef PG8_LDA
#undef PG8_LDB
#undef PG8_MMA
#undef PG8_WAIT_V
#undef PG8_WAIT_L
#undef PG8_BAR
#undef PG8_SCHED
}
}
namespace attn_body {
using bf16=__hip_bfloat16;
using bf16x8=__attribute__((ext_vector_type(8)))short;
using s16x4=__attribute__((ext_vector_type(4)))short;
using f32x16=__attribute__((ext_vector_type(16)))float;
using u32x4=__attribute__((ext_vector_type(4)))unsigned;
constexpr int BATCH=16,NHEAD=8,NKV=2,SEQ=2048,D=64,QP=512,KP=128,OP=1024,OCOL=512;
constexpr int NW=8,QBLK=32,QB=QBLK*NW,KVBLK=64,NQB=SEQ/QB;
constexpr int ATTN_UNIT_ROWS=QB;
__device__ __forceinline__ int crow(int r,int hi){return (r&3)+8*(r>>2)+4*hi;}
#define SBAR() __builtin_amdgcn_sched_barrier(0)
__device__ __forceinline__ void cmask(f32x16&p0,f32x16&p1,int jb,int qrel,int hi){
  const float NEG=-INFINITY; int kb=64*jb+4*hi;
  #pragma unroll
  for(int r=0;r<16;++r){int kv=kb+(r&3)+8*(r>>2); if(kv>qrel)p0[r]=NEG; if(kv+32>qrel)p1[r]=NEG;}
}

constexpr int NSLOT=3, SLOTB=8192;
constexpr int LDS_K=0, LDS_V=NSLOT*SLOTB, LDS_WS=2*NSLOT*SLOTB, LDS_OST=LDS_WS+NW*64*4, LDS_BYTES=LDS_OST+NW*4096;
constexpr float C2=0.125f*1.4426950408889634f;
__device__ __forceinline__ void glds16(const void*gsrc,unsigned lds_dst){unsigned keep;
  asm volatile("s_mov_b32 %0, m0\n\ts_mov_b32 m0, %2\n\ts_nop 0\n\tglobal_load_lds_dwordx4 %1, off\n\ts_mov_b32 m0, %0":"=&s"(keep):"v"(gsrc),"s"(lds_dst):"memory");}
__device__ __forceinline__ float max3f(float a,float b,float c){float r;asm("v_max3_f32 %0, %1, %2, %3":"=v"(r):"v"(a),"v"(b),"v"(c));return r;}
__device__ __forceinline__ float max2f(float a,float b){float r;asm("v_max_f32_e32 %0, %1, %2":"=v"(r):"v"(a),"v"(b));return r;}
__device__ __forceinline__ float fadd_s(float a,float b){float r;asm("v_add_f32_e32 %0, %1, %2":"=v"(r):"v"(a),"v"(b));return r;}
__device__ __forceinline__ float fsub_s(float a,float b){float r;asm("v_sub_f32_e32 %0, %1, %2":"=v"(r):"v"(a),"v"(b));return r;}
typedef float f32x2_t __attribute__((ext_vector_type(2))); typedef __bf16 bf16x2_t __attribute__((ext_vector_type(2)));
__device__ __forceinline__ unsigned cvtpk_s(float lo,float hi){f32x2_t v={lo,hi};bf16x2_t b=__builtin_convertvector(v,bf16x2_t);return __builtin_bit_cast(unsigned,b);}
#define WAIT_BAR(N) asm volatile("s_waitcnt vmcnt(" #N ") lgkmcnt(0)\n\ts_barrier":::"memory")

__device__ __forceinline__ void qkt(f32x16&p0,f32x16&p1,const char*Kslot,const bf16x8*qr,const f32x16&negm,int r32,int hi){
  const char*kb=Kslot+hi*1024+r32*16;
  #pragma unroll
  for(int d0=0;d0<4;++d0){
    const bf16x8 b0=*reinterpret_cast<const bf16x8*>(kb+d0*2048);
    const bf16x8 b1=*reinterpret_cast<const bf16x8*>(kb+d0*2048+512);
    if(d0==0){p0=__builtin_amdgcn_mfma_f32_32x32x16_bf16(b0,qr[0],negm,0,0,0);p1=__builtin_amdgcn_mfma_f32_32x32x16_bf16(b1,qr[0],negm,0,0,0);}
    else{p0=__builtin_amdgcn_mfma_f32_32x32x16_bf16(b0,qr[d0],p0,0,0,0);p1=__builtin_amdgcn_mfma_f32_32x32x16_bf16(b1,qr[d0],p1,0,0,0);}}
}
typedef __attribute__((address_space(3))) const char* lds_cptr;
typedef short v4i16_t __attribute__((ext_vector_type(4)));
__device__ __forceinline__ void kload8(bf16x8*kf,lds_cptr kp){
  kf[0]=*(const __attribute__((address_space(3))) bf16x8*)(kp);      kf[1]=*(const __attribute__((address_space(3))) bf16x8*)(kp+512);
  kf[2]=*(const __attribute__((address_space(3))) bf16x8*)(kp+2048); kf[3]=*(const __attribute__((address_space(3))) bf16x8*)(kp+2560);
  kf[4]=*(const __attribute__((address_space(3))) bf16x8*)(kp+4096); kf[5]=*(const __attribute__((address_space(3))) bf16x8*)(kp+4608);
  kf[6]=*(const __attribute__((address_space(3))) bf16x8*)(kp+6144); kf[7]=*(const __attribute__((address_space(3))) bf16x8*)(kp+6656);
}
__device__ __forceinline__ void kload2(bf16x8*kf,lds_cptr kp,int j){ kf[2*j]=*(const __attribute__((address_space(3))) bf16x8*)(kp+j*2048); kf[2*j+1]=*(const __attribute__((address_space(3))) bf16x8*)(kp+j*2048+512); }
__device__ __forceinline__ s16x4 vtr(lds_cptr p){ return __builtin_bit_cast(s16x4,__builtin_amdgcn_ds_read_tr16_b64_v4i16((__attribute__((address_space(3))) v4i16_t*)p)); }
__device__ __forceinline__ float rowmax(const f32x16&p0,const f32x16&p1){
  float a=max3f(p0[0],p0[1],p1[0]),b=max3f(p0[2],p0[3],p1[1]);a=max3f(a,p1[2],p1[3]);
  #pragma unroll
  for(int r=4;r<16;r+=4){a=max3f(a,p0[r],p0[r+1]);b=max3f(b,p0[r+2],p0[r+3]);a=max3f(a,p1[r],p1[r+1]);b=max3f(b,p1[r+2],p1[r+3]);}
  const float m=max2f(a,b);
  auto rr=__builtin_amdgcn_permlane32_swap(__float_as_uint(m),__float_as_uint(m),false,false);
  return max2f(__uint_as_float(rr[0]),__uint_as_float(rr[1]));
}
__device__ __forceinline__ void pv(f32x16*o,int vb,bf16x8 pa0,bf16x8 pa1,bf16x8 pa2,bf16x8 pa3){
  #pragma unroll
  for(int d0=0;d0<2;++d0){s16x4 lo[4],hi[4];
    #pragma unroll
    for(int ks=0;ks<4;++ks){
      asm volatile("ds_read_b64_tr_b16 %0,%1 offset:%c2":"=&v"(lo[ks]):"v"(vb),"i"(d0*4096+ks*1024):"memory");
      asm volatile("ds_read_b64_tr_b16 %0,%1 offset:%c2":"=&v"(hi[ks]):"v"(vb),"i"(d0*4096+ks*1024+512):"memory");}
    asm volatile("s_waitcnt lgkmcnt(0)":::"memory");SBAR();
    #define PK(k) (bf16x8){lo[k][0],lo[k][1],lo[k][2],lo[k][3],hi[k][0],hi[k][1],hi[k][2],hi[k][3]}
    o[d0]=__builtin_amdgcn_mfma_f32_32x32x16_bf16(pa0,PK(0),o[d0],0,0,0);
    o[d0]=__builtin_amdgcn_mfma_f32_32x32x16_bf16(pa1,PK(1),o[d0],0,0,0);
    o[d0]=__builtin_amdgcn_mfma_f32_32x32x16_bf16(pa2,PK(2),o[d0],0,0,0);
    o[d0]=__builtin_amdgcn_mfma_f32_32x32x16_bf16(pa3,PK(3),o[d0],0,0,0);
    #undef PK
  }
}

#ifndef ATTN_STORE16
#define ATTN_STORE16(p,v) (*(u32x4*)(p)=(v))
#endif
template<int THRL> __device__ __forceinline__ void attn_unit(int b,int h,int qb,const bf16*Q,const bf16*__restrict__ K,const bf16*__restrict__ V,bf16*O,float*SSB,char*shm){
  const int tid=threadIdx.x,lane=tid&63,r32=lane&31,hi=lane>>5; const int wid=__builtin_amdgcn_readfirstlane(tid>>6);
  const long rowbase=(long)b*SEQ; const int q0=qb*QB;
  const int hk=h>>2;
  const bf16*Qw=Q+(rowbase+q0+wid*QBLK)*QP+h*D;
  const bf16*Kh=K+rowbase*KP+hk*D,*Vh=V+rowbase*KP+hk*D;
  const unsigned lds0=(unsigned)(uintptr_t)shm;
  float*wsf=(float*)(shm+LDS_WS)+wid*64;
  const bf16*ksrc=Kh+(long)lane*KP+wid*8;
  const bf16*vsrc=Vh+(long)(16*(wid&3)+(lane>>2))*KP+(wid>>2)*32+(lane&3)*8;
  const unsigned kdst=lds0+LDS_K+wid*1024, vdst=lds0+LDS_V+wid*1024;
  #define DMA_K(t,slot) glds16(ksrc+(long)(t)*KVBLK*KP,(unsigned)__builtin_amdgcn_readfirstlane(kdst+(slot)))
  #define DMA_V(t,slot) glds16(vsrc+(long)(t)*KVBLK*KP,(unsigned)__builtin_amdgcn_readfirstlane(vdst+(slot)))
  const int vb0=(int)(lds0+LDS_V)+((lane>>4)&1)*32+(lane&3)*8+(4*hi+((lane&15)>>2))*64;
  const char*Kbase=shm+LDS_K; bf16x8 kf[8];
  const lds_cptr shm3=(lds_cptr)shm; const lds_cptr kp0=shm3+LDS_K+hi*1024+r32*16; const lds_cptr vp0=shm3+LDS_V+((lane>>4)&1)*32+(lane&3)*8+(4*hi+((lane&15)>>2))*64;
  const int NT=SEQ/KVBLK;
  DMA_K(0,0);DMA_V(0,0);DMA_K(1,SLOTB);
  bf16x8 qr[4];
  #pragma unroll
  for(int d0=0;d0<4;++d0)qr[d0]=*reinterpret_cast<const bf16x8*>(&Qw[(long)r32*QP+d0*16+hi*8]);
  float mhat=0.f,l_reg=0.f;f32x16 o[2];o[0]=f32x16{};o[1]=f32x16{};f32x16 negm=f32x16{};asm volatile("":"+v"(negm));
  #define CMASK(P0,P1,t) do{}while(0)
  bool resc=false;
  #define START(P0,P1) do{ const float rm=rowmax(P0,P1); resc=false; \
    { const float dl=rm; mhat=fadd_s(mhat,dl); \
      _Pragma("unroll") for(int r=0;r<16;++r){P0[r]=fsub_s(P0[r],dl);P1[r]=fsub_s(P1[r],dl);} \
      _Pragma("unroll") for(int r=0;r<16;++r)negm[r]=-mhat; asm volatile("":"+v"(negm)); } \
    _Pragma("unroll") for(int r=0;r<16;++r)P0[r]=__builtin_amdgcn_exp2f(P0[r]); }while(0)
  #define RESC() do{ if(resc){ asm volatile("s_waitcnt lgkmcnt(0)":::"memory"); \
      _Pragma("unroll") for(int d_=0;d_<2;++d_) _Pragma("unroll") for(int r=0;r<16;++r)o[d_][r]*=wsf[crow(r,hi)]; } }while(0)
  f32x16 pA0,pA1,pB0,pB1;
  int sl_prev=0,sl_cur=0,sl_next=SLOTB;
  #define ROT() do{sl_prev=sl_cur;sl_cur=sl_next;sl_next=(sl_next==(NSLOT-1)*SLOTB)?0:sl_next+SLOTB;}while(0)
  DMA_K(2,2*SLOTB);
  WAIT_BAR(3);
  qkt(pA0,pA1,Kbase,qr,negm,r32,hi);asm volatile("s_nop 15\n\ts_nop 7":"+v"(pA0),"+v"(pA1));CMASK(pA0,pA1,0);
  START(pA0,pA1);
  _Pragma("unroll") for(int r=0;r<16;++r)pA1[r]=__builtin_amdgcn_exp2f(pA1[r]);
  WAIT_BAR(0);
  DMA_K(3,0);DMA_V(1,SLOTB);
  ROT();
  kload8(kf,kp0+sl_cur);
  WAIT_BAR(2);
  s16x4 vlo[8],vhi[8]; u32x4 pw0,pw1,pw2,pw3;
  #define PKW(P,B) cvtpk_s(P[B],P[B+1])
  #define PAF(k) __builtin_bit_cast(bf16x8,pw##k)
  #define VFR(i) (bf16x8){vlo[i][0],vlo[i][1],vlo[i][2],vlo[i][3],vhi[i][0],vhi[i][1],vhi[i][2],vhi[i][3]}
  #define PIN(x) asm volatile("":"+v"(x))
  #define MX3(a,b,c) __builtin_fmaxf(__builtin_fmaxf((a),(b)),(c))
  #define GAPA(MF,A0,A1,A2,A3,W0,W1,PW) do{ MF; sacc+=A0; sacc+=A1; sacc+=A2; sacc+=A3; PIN(sacc); W0; W1; PIN(PW); SBAR(); }while(0)
  #define EX(v) __builtin_amdgcn_exp2f(v)
  #define GAPB(MF,X,B) do{ MF; X[B]=EX(X[B]); X[B+1]=EX(X[B+1]); X[B+2]=EX(X[B+2]); X[B+3]=EX(X[B+3]); PIN(X); SBAR(); }while(0)
  #define VRD(i) do{ vlo[i]=vtr(vp_+(((i)>>2)*4096+((i)&3)*1024)); vhi[i]=vtr(vp_+(((i)>>2)*4096+((i)&3)*1024+512)); }while(0)
  #define KRD(G,j) do{ if(G){ kload2(kf,kp0+sl_next,j); SBAR(); } }while(0)
  #define STEP(C0,C1,P0,P1,t,GK,GV,GL) do{ SBAR(); \
    const lds_cptr vp_=vp0+sl_prev; \
    VRD(0); SBAR(); float sacc=(P0[0]+P0[1]); \
    GAPA(C0=__builtin_amdgcn_mfma_f32_32x32x16_bf16(kf[0],qr[0],negm,0,0,0), P0[2],P0[3],P0[4],P0[5],     pw0[0]=PKW(P0,0), pw0[1]=PKW(P0,2), pw0); \
    VRD(4); SBAR(); GAPA(C1=__builtin_amdgcn_mfma_f32_32x32x16_bf16(kf[1],qr[0],negm,0,0,0), P0[6],P0[7],P0[8],P0[9],     pw0[2]=PKW(P0,4), pw0[3]=PKW(P0,6), pw0); \
    VRD(1); SBAR(); GAPA(C0=__builtin_amdgcn_mfma_f32_32x32x16_bf16(kf[2],qr[1],C0,0,0,0),   P0[10],P0[11],P0[12],P0[13], pw1[0]=PKW(P0,8), pw1[1]=PKW(P0,10), pw1); \
    VRD(5); SBAR(); GAPA(C1=__builtin_amdgcn_mfma_f32_32x32x16_bf16(kf[3],qr[1],C1,0,0,0),   P0[14],P0[15],P1[0],P1[1],   pw1[2]=PKW(P0,12),pw1[3]=PKW(P0,14), pw1); \
    VRD(2); SBAR(); GAPA(C0=__builtin_amdgcn_mfma_f32_32x32x16_bf16(kf[4],qr[2],C0,0,0,0),   P1[2],P1[3],P1[4],P1[5],     pw2[0]=PKW(P1,0), pw2[1]=PKW(P1,2), pw2); \
    VRD(6); SBAR(); GAPA(C1=__builtin_amdgcn_mfma_f32_32x32x16_bf16(kf[5],qr[2],C1,0,0,0),   P1[6],P1[7],P1[8],P1[9],     pw2[2]=PKW(P1,4), pw2[3]=PKW(P1,6), pw2); \
    VRD(3); SBAR(); GAPA(C0=__builtin_amdgcn_mfma_f32_32x32x16_bf16(kf[6],qr[3],C0,0,0,0),   P1[10],P1[11],P1[12],P1[13], pw3[0]=PKW(P1,8), pw3[1]=PKW(P1,10), pw3); \
    VRD(7); SBAR(); GAPA(C1=__builtin_amdgcn_mfma_f32_32x32x16_bf16(kf[7],qr[3],C1,0,0,0),   P1[14],P1[15],0.f,0.f,       pw3[2]=PKW(P1,12),pw3[3]=PKW(P1,14), pw3); \
    l_reg+=sacc; \
    if(GK){DMA_K((t)+3,sl_cur);} if(GV){DMA_V((t)+1,sl_next);} \
    CMASK(C0,C1,t); \
    { float a=MX3(C0[0],C0[1],C1[0]),b=MX3(C0[2],C0[3],C1[1]); a=MX3(a,C1[2],C1[3]); \
      _Pragma("unroll") for(int r=4;r<16;r+=4){a=MX3(a,C0[r],C0[r+1]);b=MX3(b,C0[r+2],C0[r+3]);a=MX3(a,C1[r],C1[r+1]);b=MX3(b,C1[r+2],C1[r+3]);} \
      float rm=__builtin_fmaxf(a,b); { auto rr=__builtin_amdgcn_permlane32_swap(__float_as_uint(rm),__float_as_uint(rm),false,false); rm=__builtin_fmaxf(__uint_as_float(rr[0]),__uint_as_float(rr[1])); } \
      resc=false; \
      if(__builtin_expect(__any(rm>(float)THRL),0)){ const float dl=__builtin_fmaxf(rm,0.f); mhat+=dl; \
        _Pragma("unroll") for(int r=0;r<16;++r){C0[r]-=dl;C1[r]-=dl;} \
        _Pragma("unroll") for(int r=0;r<16;++r)negm[r]=-mhat; asm volatile("":"+v"(negm)); \
        const float f=__builtin_amdgcn_exp2f(-dl); l_reg*=f; if(hi==0)wsf[r32]=f; resc=true; } } \
    SBAR(); \
    GAPB(o[0]=__builtin_amdgcn_mfma_f32_32x32x16_bf16(PAF(0),VFR(0),o[0],0,0,0), C0,0); \
    GAPB(o[1]=__builtin_amdgcn_mfma_f32_32x32x16_bf16(PAF(0),VFR(4),o[1],0,0,0), C0,4); \
    KRD(GL,0); GAPB(o[0]=__builtin_amdgcn_mfma_f32_32x32x16_bf16(PAF(1),VFR(1),o[0],0,0,0), C0,8); \
    KRD(GL,1); GAPB(o[1]=__builtin_amdgcn_mfma_f32_32x32x16_bf16(PAF(1),VFR(5),o[1],0,0,0), C0,12); \
    KRD(GL,2); GAPB(o[0]=__builtin_amdgcn_mfma_f32_32x32x16_bf16(PAF(2),VFR(2),o[0],0,0,0), C1,0); \
    KRD(GL,3); GAPB(o[1]=__builtin_amdgcn_mfma_f32_32x32x16_bf16(PAF(2),VFR(6),o[1],0,0,0), C1,4); \
    GAPB(o[0]=__builtin_amdgcn_mfma_f32_32x32x16_bf16(PAF(3),VFR(3),o[0],0,0,0), C1,8); \
    GAPB(o[1]=__builtin_amdgcn_mfma_f32_32x32x16_bf16(PAF(3),VFR(7),o[1],0,0,0), C1,12); \
    }while(0)
  int t=1;
  #undef CMASK
  #define CMASK(P0,P1,t) do{}while(0)
  for(;t+5<NT;t+=2){
    STEP(pB0,pB1,pA0,pA1,t,true,true,true);     WAIT_BAR(2); RESC(); ROT();
    STEP(pA0,pA1,pB0,pB1,t+1,true,true,true);   WAIT_BAR(2); RESC(); ROT();
  }
  #undef CMASK
  #define CMASK(P0,P1,t) do{}while(0)
  #define ENDW(tt) do{ if((tt)+3<NT){WAIT_BAR(2);} else if((tt)+2<NT){WAIT_BAR(1);} else {WAIT_BAR(0);} }while(0)
  for(;t+1<NT;t+=2){
    STEP(pB0,pB1,pA0,pA1,t,(t+3<NT),(t+1<NT),(t+1<NT));       ENDW(t);   RESC(); ROT();
    STEP(pA0,pA1,pB0,pB1,t+1,(t+4<NT),(t+2<NT),(t+2<NT));     ENDW(t+1); RESC(); ROT();
  }
  STEP(pB0,pB1,pA0,pA1,NT-1,false,false,false); RESC();
  { float sacc=pB0[0]+pB0[1]; _Pragma("unroll") for(int r=2;r<16;++r)sacc+=pB0[r]; _Pragma("unroll") for(int r=0;r<16;++r)sacc+=pB1[r]; l_reg+=sacc;
    pw0=(u32x4){PKW(pB0,0),PKW(pB0,2),PKW(pB0,4),PKW(pB0,6)};pw1=(u32x4){PKW(pB0,8),PKW(pB0,10),PKW(pB0,12),PKW(pB0,14)};pw2=(u32x4){PKW(pB1,0),PKW(pB1,2),PKW(pB1,4),PKW(pB1,6)};pw3=(u32x4){PKW(pB1,8),PKW(pB1,10),PKW(pB1,12),PKW(pB1,14)};
    SBAR(); pv(o,vb0+sl_cur,PAF(0),PAF(1),PAF(2),PAF(3)); }
  #undef PKW
  #undef PAF
  #undef VFR
  #undef PIN
  #undef MX3
  #undef GAPA
  #undef GAPB
  #undef EX
  #undef VRD
  #undef KRD
  #undef STEP
  #undef ENDW
  {auto rr=__builtin_amdgcn_permlane32_swap(__float_as_uint(l_reg),__float_as_uint(l_reg),false,false);l_reg=__uint_as_float(rr[0])+__uint_as_float(rr[1]);}
  if(hi==0)wsf[32+r32]=l_reg;asm volatile("s_waitcnt lgkmcnt(0)":::"memory");
  float rli[16];
  #pragma unroll
  for(int r=0;r<16;++r)rli[r]=__builtin_amdgcn_rcpf(wsf[32+crow(r,hi)]);
  bf16*Ow=O+(rowbase+q0+wid*QBLK)*OP+OCOL+h*D; float*Sw=SSB+(rowbase+q0+wid*QBLK)*NHEAD+h;
  { bf16*stg=(bf16*)(shm+LDS_OST)+wid*2048;
    #pragma unroll
    for(int r=0;r<16;++r){const int orow=crow(r,hi);
      #pragma unroll
      for(int d0=0;d0<2;++d0)stg[orow*64+d0*32+r32]=__float2bfloat16(o[d0][r]*rli[r]);}
    asm volatile("s_waitcnt lgkmcnt(0)":::"memory");
    #pragma unroll
    for(int i=0;i<4;++i){const int row=i*8+(lane>>3),ch=lane&7; const u32x4 v=*(const u32x4*)(stg+row*64+ch*8); ATTN_STORE16(Ow+(long)row*OP+ch*8,v);
      float ss=0.f;
      #pragma unroll
      for(int j=0;j<4;++j){const float lo=__builtin_bit_cast(float,v[j]<<16),hi2=__builtin_bit_cast(float,v[j]&0xffff0000u); ss+=lo*lo+hi2*hi2;}
      ss+=__shfl_xor(ss,1);ss+=__shfl_xor(ss,2);ss+=__shfl_xor(ss,4); if(ch==0)Sw[(long)row*NHEAD]=ss;} }
  asm volatile("s_waitcnt lgkmcnt(0)\n\ts_barrier":::"memory");
  #undef DMA_K
  #undef DMA_V
  #undef CMASK
  #undef START
  #undef RESC
  #undef ROT
}
constexpr int ATTN_LDS_BYTES=LDS_BYTES;
struct AttnTensors { const bf16* Q; const bf16* K; const bf16* V; bf16* O; float* SSB; };
struct AttnUnit { int bh; int qb; };
struct StaticOrder {
  int vcu,G;
  __device__ __forceinline__ explicit StaticOrder(int grid,int v):vcu(v),G(grid){}
  __device__ __forceinline__ bool next(int i,AttnUnit&u)const{
    if(G==256){ if(i>=4)return false; const int grp=4*(vcu>>5)+i,l=vcu&31; u.bh=(grp>>1)*NHEAD+(grp&1)*4+(l>>3); u.qb=l&7; return true; }
    const long L=(long)i*G+vcu; if(L>=(long)BATCH*NHEAD*NQB)return false; u.bh=(int)(L/NQB); u.qb=(int)(L%NQB); return true; }
};
template<class Sched,int THRL=8> __device__ __forceinline__ void attn_phase(char*lds,const AttnTensors&T,const Sched&S){
  AttnUnit u;
  for(int i=0;S.next(i,u);++i){ attn_unit<THRL>(u.bh/NHEAD,u.bh%NHEAD,u.qb,T.Q,T.K,T.V,T.O,T.SSB,lds); }
}
#undef SBAR
#undef WAIT_BAR
}
#define GAS __attribute__((address_space(1)))
#define LAS __attribute__((address_space(3)))
typedef unsigned v4u __attribute__((ext_vector_type(4)));
typedef float f32x4 __attribute__((ext_vector_type(4)));
typedef short bf16x8 __attribute__((ext_vector_type(8)));
typedef GAS unsigned gu32;
typedef GAS unsigned long long gu64;
#define RLX_AGENT __ATOMIC_RELAXED, __HIP_MEMORY_SCOPE_AGENT
#define LDS_WAIT() asm volatile("s_waitcnt lgkmcnt(0)" ::: "memory")
#define VM_WAIT() asm volatile("s_waitcnt vmcnt(0)" ::: "memory")
__device__ __forceinline__ unsigned long long rt() { return __builtin_amdgcn_s_memrealtime(); }
__device__ __forceinline__ unsigned pk2(float lo, float hi) { return f2bf(lo) | (f2bf(hi) << 16); }

#define XB_TMO      128
#define XB_XCNT(j)  (256  + 64 * (j))
#define XB_XSUB(j)  (1280 + 64 * (j))
#define XB_XGEN(j)  (2304 + 64 * (j))
#define XB_TOP      3328
#define XB_TOPGEN   3392
#define XCD_BAR_WORDS 3456
#define XB_SPIN_CAP (1u << 18)

__device__ __forceinline__ unsigned xb_ld(unsigned* p)              { return __hip_atomic_load(p, __ATOMIC_RELAXED, __HIP_MEMORY_SCOPE_AGENT); }
__device__ __forceinline__ unsigned xb_add(unsigned* p, unsigned v) { return __hip_atomic_fetch_add(p, v, __ATOMIC_RELAXED, __HIP_MEMORY_SCOPE_AGENT); }
__device__ __forceinline__ unsigned xb_xcc_id() { return (unsigned)__builtin_amdgcn_s_getreg((3 << 11) | 20) & 0xFu; }
#define XB_SPIN(cond, bar) do { unsigned _sp = 0; while (cond) { __builtin_amdgcn_s_sleep(1); \
    if ((++_sp & 255u) == 0u) { if (xb_ld(&(bar)[XB_TMO])) break; if (_sp > XB_SPIN_CAP) { atomicAdd(&(bar)[XB_TMO], 1u); break; } } } } while (0)

struct XcdBarrier {
    unsigned* bar; unsigned x;
    volatile LAS unsigned* st;
};

__device__ __forceinline__ XcdBarrier xcd_barrier_post(unsigned* bar, volatile LAS unsigned* st) {
    XcdBarrier b; b.bar = bar; b.x = xb_xcc_id(); b.st = st;
    if (threadIdx.x == 0) (void)xb_add(&bar[XB_XCNT(b.x)], 1u);
    return b;
}
__device__ __forceinline__ void xcd_barrier_complete(unsigned* bar, unsigned x, unsigned& nloc, unsigned& nx) {
    const unsigned G = gridDim.x * gridDim.y * gridDim.z;
    unsigned sum, cnt, mine, sp = 0u;
    for (;;) {
        sum = 0u; cnt = 0u; mine = 0u;
#pragma unroll
        for (unsigned j = 0; j < 16; ++j) { const unsigned c = xb_ld(&bar[XB_XCNT(j)]); sum += c; cnt += (c > 0u) ? 1u : 0u; mine = (j == x) ? c : mine; }
        if (sum == G) break;
        __builtin_amdgcn_s_sleep(1);
        if ((++sp & 255u) == 0u) { if (xb_ld(&bar[XB_TMO])) break; if (sp > XB_SPIN_CAP) { atomicAdd(&bar[XB_TMO], 1u); break; } }
    }
    nloc = mine > 0u ? mine : 1u; nx = cnt > 0u ? cnt : 1u;
}

__device__ __forceinline__ void xcd_barrier(const XcdBarrier& b) {
    asm volatile("s_waitcnt vmcnt(0)" ::: "memory");
    __syncthreads();
    if (threadIdx.x == 0) {
        unsigned* bar = b.bar;
        __builtin_amdgcn_s_waitcnt(0);
        unsigned nloc = b.st[0], nx = b.st[1];
        if (nloc == 0u) { xcd_barrier_complete(bar, b.x, nloc, nx); b.st[0] = nloc; b.st[1] = nx; }
        const unsigned old = xb_add(&bar[XB_XSUB(b.x)], 1u);
        const unsigned gen = old / nloc;
        if (old + 1u == (gen + 1u) * nloc) {
            __builtin_amdgcn_fence(__ATOMIC_RELEASE, "agent");
            asm volatile("s_waitcnt vmcnt(0)" ::: "memory");
            const unsigned og = xb_add(&bar[XB_TOP], 1u);
            const unsigned tg = og / nx;
            if (og + 1u == (tg + 1u) * nx) xb_add(&bar[XB_TOPGEN], 1u);
            else XB_SPIN(xb_ld(&bar[XB_TOPGEN]) == tg, bar);
            __builtin_amdgcn_fence(__ATOMIC_ACQUIRE, "agent");
            xb_add(&bar[XB_XGEN(b.x)], 1u);
            asm volatile("s_waitcnt vmcnt(0)" ::: "memory");
        } else {
            XB_SPIN(xb_ld(&bar[XB_XGEN(b.x)]) == gen, bar);
            __builtin_amdgcn_fence(__ATOMIC_ACQUIRE, "agent");
            asm volatile("s_waitcnt vmcnt(0)" ::: "memory");
        }
    }
    __syncthreads();
}
constexpr int NWAVES = 8;
constexpr int RING_OFF = 0, RING_BYTES = 131072;
constexpr int LDSCTL_OFF = RING_BYTES, MISC_OFF = LDSCTL_OFF + 320;
constexpr int LDS_BYTES = 147456;
constexpr int CW_TMO = 0, CW_CODE = 1, CW_BAR = 4096;
constexpr int N_PHASES = 10;

struct Frame {
    LAS unsigned char* lds;
    volatile LAS unsigned* MISC;
    gu32* ctl;
    int tid, lane, wave, vcu, G;
};
struct Args { const float* in[17]; float* out; unsigned char* ws; int ph_lo, ph_hi, li, pad; };

__device__ __forceinline__ float gelu_fast(float x) {
    const float t = x * (-2.3022082f + -0.10294324f * x * x);
    return x * __builtin_amdgcn_rcpf(1.0f + __builtin_amdgcn_exp2f(t));
}
struct EpiInProj {
    static constexpr bool PERM = true;
    bf16 *U, *VG, *Q, *Kb, *Vb; const float *gv, *gq, *gk, *cosT, *sinT;
    __device__ __forceinline__ void operator()(const pg8::f32x4 (&acc)[2][2][4][2], const pg8::Unit& u, int wr, int wc, int fr, int fq) const {
        using pg8::f32x4; using pg8::u32x4;
        const int pn = u.pn;
        int kind, head;
        if (pn < 2) { kind = 0; head = pn * 4 + wc; } else if (pn < 4) { kind = 1; head = (pn - 2) * 4 + wc; } else if (pn < 6) { kind = 2; head = (pn - 4) * 4 + wc; } else { kind = (wc < 2) ? 3 : 4; head = wc & 1; }
        bf16* outp; int pitch; const float* gp = gq;
        if (kind == 0) { outp = U + head * 64; pitch = AW; } else if (kind == 1) { outp = VG + head * 64; pitch = AW; gp = gv + head * 64; }
        else if (kind == 2) { outp = Q + head * 64; pitch = BW; gp = gq; } else if (kind == 3) { outp = Kb + head * 64; pitch = KVW; gp = gk; } else { outp = Vb + head * 64; pitch = KVW; }
        const int dl = 8 * fq, fi = 8 * (fq & 1);
        f32x4 gg[2][2];
#pragma unroll
        for (int bj = 0; bj < 2; ++bj)
#pragma unroll
            for (int n = 0; n < 2; ++n) gg[bj][n] = *(const f32x4*)(gp + 32 * bj + dl + 4 * n);
#pragma unroll
        for (int ai = 0; ai < 2; ++ai)
#pragma unroll
            for (int m = 0; m < 4; ++m) {
                const int row = u.pm * 256 + ai * 128 + wr * 64 + m * 16 + fr;
                f32x4 v[2][2];
#pragma unroll
                for (int bj = 0; bj < 2; ++bj)
#pragma unroll
                    for (int n = 0; n < 2; ++n) v[bj][n] = acc[ai][bj][m][n];
                if (kind <= 1) {
#pragma unroll
                    for (int bj = 0; bj < 2; ++bj)
#pragma unroll
                        for (int n = 0; n < 2; ++n)
#pragma unroll
                            for (int e = 0; e < 4; ++e) v[bj][n][e] = gelu_fast(v[bj][n][e]);
                }
                if (kind >= 1 && kind <= 3) {
                    float ss = 0.f;
#pragma unroll
                    for (int bj = 0; bj < 2; ++bj)
#pragma unroll
                        for (int n = 0; n < 2; ++n)
#pragma unroll
                            for (int e = 0; e < 4; ++e) ss += v[bj][n][e] * v[bj][n][e];
                    ss += __shfl_xor(ss, 16); ss += __shfl_xor(ss, 32);
                    const float rstd = rsqrtf(ss * (1.0f / 64.0f) + EPS);
#pragma unroll
                    for (int bj = 0; bj < 2; ++bj)
#pragma unroll
                        for (int n = 0; n < 2; ++n) v[bj][n] = v[bj][n] * rstd * gg[bj][n];
                }
                if (kind == 2 || kind == 3) {
                    const int t = row & (SEQ - 1);
                    const float sc = (kind == 2) ? QSCALE : 1.0f;
#pragma unroll
                    for (int bj = 0; bj < 2; ++bj) {
                        const int pos = bj ? (t & 63) : (t >> 6);
#pragma unroll
                        for (int n = 0; n < 2; ++n) {
                            const f32x4 c4 = *(const f32x4*)(cosT + pos * 16 + fi + 4 * n), s4 = *(const f32x4*)(sinT + pos * 16 + fi + 4 * n);
#pragma unroll
                            for (int e = 0; e < 4; ++e) {
                                const float me = v[bj][n][e], pa = __shfl_xor(me, 32);
                                const float o = (fq < 2) ? (me * c4[e] - pa * s4[e]) : (me * c4[e] + pa * s4[e]);
                                v[bj][n][e] = o * sc;
                            }
                        }
                    }
                }
#pragma unroll
                for (int bj = 0; bj < 2; ++bj) {
                    u32x4 w; w.x = pg8::cvt_pk_bf16(v[bj][0][0], v[bj][0][1]); w.y = pg8::cvt_pk_bf16(v[bj][0][2], v[bj][0][3]); w.z = pg8::cvt_pk_bf16(v[bj][1][0], v[bj][1][1]); w.w = pg8::cvt_pk_bf16(v[bj][1][2], v[bj][1][3]);
                    *(u32x4*)(outp + (size_t)row * pitch + 32 * bj + dl) = w;
                }
            }
    }
};


struct EpiOutProj {
    static constexpr bool PERM = true;
    const float* x; const float* SSB; float* X1; bf16* X1B;
    __device__ __forceinline__ void operator()(const pg8::f32x4 (&acc)[2][2][4][2], const pg8::Unit& u, int wr, int wc, int fr, int fq) const {
        using pg8::f32x4; using pg8::u32x4;
        const int col0 = u.pn * 256 + wc * 32 + 8 * fq;
#pragma unroll
        for (int ai = 0; ai < 2; ++ai)
#pragma unroll
            for (int m = 0; m < 4; ++m) {
                const size_t row = (size_t)(u.pm * 256 + ai * 128 + wr * 64 + m * 16 + fr);
                const f32x4 s0 = *(const f32x4*)(SSB + row * 8), s1 = *(const f32x4*)(SSB + row * 8 + 4);
                const float rstd_b = rsqrtf(((s0[0] + s0[1]) + (s0[2] + s0[3]) + (s1[0] + s1[1]) + (s1[2] + s1[3])) * (1.0f / BW) + EPS);
#pragma unroll
                for (int bj = 0; bj < 2; ++bj) {
                    const size_t off = row * DM + col0 + bj * 128;
                    const f32x4 x0 = *(const f32x4*)(x + off), x1 = *(const f32x4*)(x + off + 4);
                    const f32x4 o0 = x0 + acc[ai][bj][m][0] * rstd_b, o1 = x1 + acc[ai][bj][m][1] * rstd_b;
                    *(f32x4*)(X1 + off) = o0; *(f32x4*)(X1 + off + 4) = o1;
                    u32x4 w; w.x = pg8::cvt_pk_bf16(o0[0], o0[1]); w.y = pg8::cvt_pk_bf16(o0[2], o0[3]); w.z = pg8::cvt_pk_bf16(o1[0], o1[1]); w.w = pg8::cvt_pk_bf16(o1[2], o1[3]);
                    *(u32x4*)(X1B + off) = w;
                }
            }
    }
};

struct EpiGateUp {
    static constexpr bool PERM = true;
    const int* IDX; const float* RS2; bf16* HH;
    __device__ __forceinline__ void operator()(const pg8::f32x4 (&acc)[2][2][4][2], const pg8::Unit& u, int wr, int wc, int fr, int fq) const {
        using pg8::f32x4; using pg8::u32x4;
        const int col0 = u.pn * 128 + wc * 32 + 8 * fq;
#pragma unroll
        for (int ai = 0; ai < 2; ++ai)
#pragma unroll
            for (int m = 0; m < 4; ++m) {
                const size_t slot = (size_t)(u.pm * 256 + ai * 128 + wr * 64 + m * 16 + fr);
                const float rs = RS2[IDX[slot]];
                float h[8];
#pragma unroll
                for (int n = 0; n < 2; ++n)
#pragma unroll
                    for (int e = 0; e < 4; ++e) { const float a = acc[ai][0][m][n][e] * rs, b = acc[ai][1][m][n][e] * rs;
                        h[4 * n + e] = a * __builtin_amdgcn_rcpf(1.0f + __builtin_amdgcn_exp2f(-1.4426950408889634f * a)) * b; }
                u32x4 w; w.x = pg8::cvt_pk_bf16(h[0], h[1]); w.y = pg8::cvt_pk_bf16(h[2], h[3]); w.z = pg8::cvt_pk_bf16(h[4], h[5]); w.w = pg8::cvt_pk_bf16(h[6], h[7]);
                *(u32x4*)(HH + slot * EFF + col0) = w;
            }
    }
};
struct EpiDown {
    static constexpr bool PERM = true;
    const float* GSEL; bf16* Y;
    __device__ __forceinline__ void operator()(const pg8::f32x4 (&acc)[2][2][4][2], const pg8::Unit& u, int wr, int wc, int fr, int fq) const {
        using pg8::f32x4; using pg8::u32x4;
        const int col0 = u.pn * 256 + wc * 32 + 8 * fq;
#pragma unroll
        for (int ai = 0; ai < 2; ++ai)
#pragma unroll
            for (int m = 0; m < 4; ++m) {
                const size_t slot = (size_t)(u.pm * 256 + ai * 128 + wr * 64 + m * 16 + fr);
                const float g = GSEL[slot];
#pragma unroll
                for (int bj = 0; bj < 2; ++bj) {
                    const f32x4 o0 = acc[ai][bj][m][0] * g, o1 = acc[ai][bj][m][1] * g;
                    u32x4 w; w.x = pg8::cvt_pk_bf16(o0[0], o0[1]); w.y = pg8::cvt_pk_bf16(o0[2], o0[3]); w.z = pg8::cvt_pk_bf16(o1[0], o1[1]); w.w = pg8::cvt_pk_bf16(o1[2], o1[3]);
                    *(u32x4*)(Y + slot * DM + col0 + bj * 128) = w;
                }
            }
    }
};

__device__ __forceinline__ void p0_item(const float* W, int ldw, const float* gs, int k0, int n0, bf16* WT, int Kp, int prow0, LAS float* scr, int lane) {
    float w[32];
    const float* wp = W + (size_t)(k0 + (lane >> 5)) * ldw + n0 + (lane & 31);
#pragma unroll
    for (int i = 0; i < 32; ++i) w[i] = wp[(size_t)(2 * i) * ldw];
    if (gs) {
#pragma unroll
        for (int i = 0; i < 32; ++i) w[i] *= gs[2 * i + (lane >> 5)];
    }
#pragma unroll
    for (int i = 0; i < 32; ++i) scr[(2 * i + (lane >> 5)) * 33 + (lane & 31)] = w[i];
    LDS_WAIT(); asm volatile("" ::: "memory");
    const int c = lane & 7;
#pragma unroll
    for (int j = 0; j < 4; ++j) { const int n = (lane >> 3) + 8 * j; const LAS float* s = scr + (8 * c) * 33 + n;
        v4u o; o.x = pk2(s[0 * 33], s[1 * 33]); o.y = pk2(s[2 * 33], s[3 * 33]); o.z = pk2(s[4 * 33], s[5 * 33]); o.w = pk2(s[6 * 33], s[7 * 33]);
        *(GAS v4u*)(WT + (size_t)(prow0 + n) * Kp + k0 + 8 * c) = o; }
    LDS_WAIT(); asm volatile("" ::: "memory");
}
__device__ __forceinline__ void p0_prologue(Frame& F, const Args& a) {
    unsigned char* ws = a.ws;
    const float* x = a.in[0]; const float* g_mix = a.in[1]; const float* w_in = a.in[2]; const float* g_a = a.in[8]; const float* g_b = a.in[9]; const float* w_out = a.in[10];
    const float* g_ffn = a.in[11]; const float* w_gate = a.in[13]; const float* w_up = a.in[14]; const float* w_down = a.in[15];
    bf16* Win_t = (bf16*)(ws + WS_WIN); bf16* Wout_t = (bf16*)(ws + WS_WOUT); bf16* Wgu_t = (bf16*)(ws + WS_WGU); bf16* Wd_t = (bf16*)(ws + WS_WD); bf16* XN = (bf16*)(ws + WS_XN);
    LAS float* scr = (LAS float*)(F.lds + RING_OFF + F.wave * 16384);
    const int gw = F.vcu * NWAVES + F.wave, NGW = F.G * NWAVES;
    constexpr int I_IN = (DM / 64) * (INW / 32), I_OUT = (DM / 64) * (DM / 32), I_E = (DM / 64) * (EFF / 32), I_EXP = NE * I_E;
    constexpr int NITEMS = I_IN + I_OUT + 3 * I_EXP;
    for (int it = gw; it < NITEMS; it += NGW) {
        int r = it;
        if (r < I_IN) { const int kb = r / (INW / 32), nb = r % (INW / 32), k0 = 64 * kb, L0 = 32 * nb, j = L0 >> 8, Lt = L0 & 255;
            p0_item(w_in, INW, g_mix + k0, k0, L0, Win_t, DM, 256 * j + 128 * ((Lt & 63) >> 5) + 32 * (Lt >> 6), scr, F.lane); continue; }
        r -= I_IN;
        if (r < I_OUT) { const int kb = r / (DM / 32), nb = r % (DM / 32), k0 = 64 * kb;
            p0_item(w_out, DM, (k0 < AW ? g_a + k0 : g_b + (k0 - AW)), k0, 32 * nb, Wout_t, DM, 32 * nb, scr, F.lane); continue; }
        r -= I_OUT;
        if (r < 2 * I_EXP) { const int up = r >= I_EXP; if (up) r -= I_EXP; const int e = r / I_E, q = r % I_E, kb = q / (EFF / 32), nb = q % (EFF / 32), k0 = 64 * kb, n0 = 32 * nb;
            p0_item((up ? w_up : w_gate) + (size_t)e * DM * EFF, EFF, g_ffn + k0, k0, n0, Wgu_t, DM, e * 2048 + 256 * (n0 >> 7) + 128 * up + (n0 & 127), scr, F.lane); continue; }
        r -= 2 * I_EXP;
        { const int e = r / I_E, q = r % I_E, kb = q / (DM / 32), nb = q % (DM / 32), k0 = 64 * kb, n0 = 32 * nb;
            p0_item(w_down + (size_t)e * EFF * DM, DM, nullptr, k0, n0, Wd_t, EFF, e * DM + n0, scr, F.lane); }
    }
    for (int m = gw; m < T; m += 2 * NGW) {
        const int m2 = (m + NGW < T) ? m + NGW : m;
        const GAS f32x4* xa = (const GAS f32x4*)(x + (size_t)m * DM) + F.lane; const GAS f32x4* xb = (const GAS f32x4*)(x + (size_t)m2 * DM) + F.lane;
        f32x4 va[4], vb[4]; float sa = 0.f, sb = 0.f;
#pragma unroll
        for (int j = 0; j < 4; ++j) { va[j] = xa[64 * j]; vb[j] = xb[64 * j]; }
#pragma unroll
        for (int j = 0; j < 4; ++j) { sa += (va[j].x * va[j].x + va[j].y * va[j].y) + (va[j].z * va[j].z + va[j].w * va[j].w); sb += (vb[j].x * vb[j].x + vb[j].y * vb[j].y) + (vb[j].z * vb[j].z + vb[j].w * vb[j].w); }
#pragma unroll
        for (int o = 1; o < 64; o <<= 1) { sa += __shfl_xor(sa, o); sb += __shfl_xor(sb, o); }
        const float ra = rsqrtf(sa * (1.0f / DM) + EPS), rb = rsqrtf(sb * (1.0f / DM) + EPS);
        GAS unsigned long long* oa = (GAS unsigned long long*)(XN + (size_t)m * DM) + F.lane; GAS unsigned long long* ob = (GAS unsigned long long*)(XN + (size_t)m2 * DM) + F.lane;
#pragma unroll
        for (int j = 0; j < 4; ++j) { oa[64 * j] = (unsigned long long)pk2(va[j].x * ra, va[j].y * ra) | ((unsigned long long)pk2(va[j].z * ra, va[j].w * ra) << 32);
                                      ob[64 * j] = (unsigned long long)pk2(vb[j].x * rb, vb[j].y * rb) | ((unsigned long long)pk2(vb[j].z * rb, vb[j].w * rb) << 32); }
    }
    { const float* w_s = a.in[4]; bf16* Wsb = (bf16*)(ws + WS_WS); const int gt0 = (F.vcu * NWAVES + F.wave) * 64 + F.lane;
      for (int i = gt0; i < AH * CHUNK * CHUNK / 4; i += NGW * 64) { const f32x4 w4 = *(const f32x4*)(w_s + 4 * i); *(unsigned long long*)(Wsb + 4 * i) = (unsigned long long)pk2(w4[0], w4[1]) | ((unsigned long long)pk2(w4[2], w4[3]) << 32); } }
    { int* INV = (int*)(ws + WS_INV); const int gt = (F.vcu * NWAVES + F.wave) * 64 + F.lane, NGT = NGW * 64;
      for (int i = gt; i < T * NE / 4; i += NGT) ((GAS v4u*)INV)[i] = (v4u){0xffffffffu, 0xffffffffu, 0xffffffffu, 0xffffffffu};
      if (gt < 64 * 16) { float* cosT = (float*)(ws + WS_ROPE); float* sinT = cosT + 1024; const int pos = gt >> 4, i = gt & 15;
          const float ang = (float)pos * powf(10000.0f, -(float)i / 16.0f); cosT[gt] = cosf(ang); sinT[gt] = sinf(ang); } }
}

template <int M> __device__ __forceinline__ float swz_xor(float v) { return __builtin_bit_cast(float, __builtin_amdgcn_ds_swizzle(__builtin_bit_cast(int, v), 0x1f | (M << 10))); }

constexpr int VTS = 136;
__device__ __forceinline__ void p3_gmlp(Frame& F, const Args& a) {
    unsigned char* ws = a.ws;
    const bf16* U = (const bf16*)(ws + WS_U); const bf16* VG = (const bf16*)(ws + WS_VG); const bf16* Wsb = (const bf16*)(ws + WS_WS); const float* b_s = a.in[5];
    const float* SSB = (const float*)(ws + WS_SSB); bf16* A2 = (bf16*)(ws + WS_A2);
    LAS bf16* vt = (LAS bf16*)(F.lds + RING_OFF);
    const int w = F.wave, l = F.lane, pr = l & 15, dq = l >> 4, tq = F.tid >> 2, tdc = F.tid & 3;
    for (int unit = F.vcu; unit < BATCH * (SEQ / CHUNK); unit += F.G) {
        const size_t row0 = (size_t)unit * CHUNK, row = row0 + 16 * w + pr;
        float av[8][4][4]; float ss = 0.f;
#pragma unroll
        for (int h = 0; h < 8; ++h) {
            __syncthreads();
            { const bf16* src = VG + (row0 + tq) * AW + h * 64 + tdc * 16; const v4u x0 = *(const v4u*)src, x1 = *(const v4u*)(src + 8);
#pragma unroll
              for (int j = 0; j < 4; ++j) { vt[(tdc * 16 + 2 * j) * VTS + tq] = (bf16)(x0[j] & 0xffffu); vt[(tdc * 16 + 2 * j + 1) * VTS + tq] = (bf16)(x0[j] >> 16);
                                            vt[(tdc * 16 + 8 + 2 * j) * VTS + tq] = (bf16)(x1[j] & 0xffffu); vt[(tdc * 16 + 8 + 2 * j + 1) * VTS + tq] = (bf16)(x1[j] >> 16); } }
            __syncthreads();
            bf16x8 bw[4];
#pragma unroll
            for (int ks = 0; ks < 4; ++ks) bw[ks] = *(const bf16x8*)(Wsb + ((size_t)(h * CHUNK + 16 * w + pr) * CHUNK + 32 * ks + 8 * dq));
            const float bias = b_s[h * CHUNK + 16 * w + pr];
#pragma unroll
            for (int mt = 0; mt < 4; ++mt) {
                f32x4 acc = (f32x4){0.f, 0.f, 0.f, 0.f};
#pragma unroll
                for (int ks = 0; ks < 4; ++ks) { const bf16x8 af = *(const LAS bf16x8*)(vt + (16 * mt + pr) * VTS + 32 * ks + 8 * dq); acc = __builtin_amdgcn_mfma_f32_16x16x32_bf16(af, bw[ks], acc, 0, 0, 0); }
                const unsigned long long u4 = *(const unsigned long long*)(U + row * AW + h * 64 + 16 * mt + 4 * dq);
#pragma unroll
                for (int r = 0; r < 4; ++r) { const float uv = __builtin_bit_cast(float, (unsigned)((u4 >> (16 * r)) & 0xffffull) << 16); const float o = uv * (acc[r] + bias); av[h][mt][r] = o; ss += o * o; }
            }
        }
        ss += __shfl_xor(ss, 16); ss += __shfl_xor(ss, 32);
        const f32x4 s0 = *(const f32x4*)(SSB + row * 8), s1 = *(const f32x4*)(SSB + row * 8 + 4);
        const float rstd_b = rsqrtf(((s0[0] + s0[1]) + (s0[2] + s0[3]) + (s1[0] + s1[1]) + (s1[2] + s1[3])) * (1.0f / BW) + EPS);
        const float sc = rsqrtf(ss * (1.0f / AW) + EPS) / rstd_b;
#pragma unroll
        for (int h = 0; h < 8; ++h)
#pragma unroll
            for (int mt = 0; mt < 4; ++mt) {
                const unsigned long long o = (unsigned long long)pk2(av[h][mt][0] * sc, av[h][mt][1] * sc) | ((unsigned long long)pk2(av[h][mt][2] * sc, av[h][mt][3] * sc) << 32);
                *(unsigned long long*)(A2 + row * DM + h * 64 + 16 * mt + 4 * dq) = o;
            }
    }
    __syncthreads();
}
constexpr int WRS = 20;
__device__ __forceinline__ void p5_router(Frame& F, const Args& a) {
    unsigned char* ws = a.ws; const float* X1 = a.out; const float* gf = a.in[11]; const float* wr = a.in[12];
    float* AFF = (float*)(ws + WS_AFF); float* RS2 = (float*)(ws + WS_RS2);
    LAS float* wl = (LAS float*)(F.lds + RING_OFF);
    __syncthreads();
    for (int i = F.tid; i < DM * NE / 4; i += NWAVES * 64) { const int c = i >> 2, q = i & 3; const f32x4 w4 = *(const f32x4*)(wr + 4 * i) * gf[c]; *(LAS f32x4*)(wl + c * WRS + 4 * q) = w4; }
    __syncthreads();
    const int gw = F.vcu * NWAVES + F.wave, NGW = F.G * NWAVES, lane = F.lane;
    for (int grp = gw; grp < T / 4; grp += NGW) {
        const int row0 = grp * 4;
        float acc[64]; float ss[4] = {0.f, 0.f, 0.f, 0.f};
#pragma unroll
        for (int j = 0; j < 64; ++j) acc[j] = 0.f;
#pragma unroll 1
        for (int hf = 0; hf < 4; ++hf) {
            float xv[4][4];
#pragma unroll
            for (int r = 0; r < 4; ++r)
#pragma unroll
                for (int i = 0; i < 4; ++i) xv[r][i] = X1[(size_t)(row0 + r) * DM + (hf * 4 + i) * 64 + lane];
#pragma unroll
            for (int i = 0; i < 4; ++i) {
                const LAS float* wp = wl + ((hf * 4 + i) * 64 + lane) * WRS;
                const f32x4 w0 = *(const LAS f32x4*)(wp), w1 = *(const LAS f32x4*)(wp + 4), w2 = *(const LAS f32x4*)(wp + 8), w3 = *(const LAS f32x4*)(wp + 12);
#pragma unroll
                for (int r = 0; r < 4; ++r) { const float x = xv[r][i]; ss[r] += x * x;
#pragma unroll
                    for (int e = 0; e < 4; ++e) { acc[r * 16 + e] += x * w0[e]; acc[r * 16 + 4 + e] += x * w1[e]; acc[r * 16 + 8 + e] += x * w2[e]; acc[r * 16 + 12 + e] += x * w3[e]; } }
            }
        }
        __builtin_amdgcn_sched_barrier(0);
        float b32[32], c16[16], d8[8], e4[4], f2[2], g1;
        { const bool up = lane & 32;
#pragma unroll
          for (int j = 0; j < 32; ++j) { const float send = up ? acc[j] : acc[32 + j], keep = up ? acc[32 + j] : acc[j]; b32[j] = keep + __shfl_xor(send, 32); } }
        __builtin_amdgcn_sched_barrier(0);
        { const bool up = lane & 16;
#pragma unroll
          for (int j = 0; j < 16; ++j) { const float send = up ? b32[j] : b32[16 + j], keep = up ? b32[16 + j] : b32[j]; c16[j] = keep + swz_xor<16>(send); } }
        { const bool up = lane & 8;
#pragma unroll
          for (int j = 0; j < 8; ++j) { const float send = up ? c16[j] : c16[8 + j], keep = up ? c16[8 + j] : c16[j]; d8[j] = keep + swz_xor<8>(send); } }
        { const bool up = lane & 4;
#pragma unroll
          for (int j = 0; j < 4; ++j) { const float send = up ? d8[j] : d8[4 + j], keep = up ? d8[4 + j] : d8[j]; e4[j] = keep + swz_xor<4>(send); } }
        { const bool up = lane & 2;
#pragma unroll
          for (int j = 0; j < 2; ++j) { const float send = up ? e4[j] : e4[2 + j], keep = up ? e4[2 + j] : e4[j]; f2[j] = keep + swz_xor<2>(send); } }
        { const bool up = lane & 1; const float send = up ? f2[0] : f2[1], keep = up ? f2[1] : f2[0]; g1 = keep + swz_xor<1>(send); }
        __builtin_amdgcn_sched_barrier(0);
        float s2[2], s1;
        { const bool up = lane & 32;
#pragma unroll
          for (int j = 0; j < 2; ++j) { const float send = up ? ss[j] : ss[2 + j], keep = up ? ss[2 + j] : ss[j]; s2[j] = keep + __shfl_xor(send, 32); } }
        { const bool up = lane & 16; const float send = up ? s2[0] : s2[1], keep = up ? s2[1] : s2[0]; s1 = keep + swz_xor<16>(send); }
        s1 += swz_xor<8>(s1); s1 += swz_xor<4>(s1); s1 += swz_xor<2>(s1); s1 += swz_xor<1>(s1);
        const float rstd = rsqrtf(s1 * (1.0f / DM) + EPS);
        const float lg = g1 * rstd;
        float mx = lg; mx = fmaxf(mx, swz_xor<8>(mx)); mx = fmaxf(mx, swz_xor<4>(mx)); mx = fmaxf(mx, swz_xor<2>(mx)); mx = fmaxf(mx, swz_xor<1>(mx));
        const float ex = expf(lg - mx);
        float den = ex; den += swz_xor<8>(den); den += swz_xor<4>(den); den += swz_xor<2>(den); den += swz_xor<1>(den);
        const int row = row0 + (lane >> 4), e = lane & 15, b = row / SEQ, sq = row % SEQ;
        AFF[((size_t)b * NE + e) * SEQ + sq] = ex / den;
        if (e == 0) RS2[row] = rstd;
    }
    __syncthreads();
}
__device__ __forceinline__ void p6_topk(Frame& F, const Args& a) {
    unsigned char* ws = a.ws; const float* AFF = (const float*)(ws + WS_AFF);
    int* IDX = (int*)(ws + WS_IDX); float* GSEL = (float*)(ws + WS_GSEL); int* INV = (int*)(ws + WS_INV);
    const int lane = F.lane;
    if (F.wave != 0) return;
    for (int be = F.vcu; be < BATCH * NE; be += F.G) {
        const int b = be / NE, e = be % NE;
        unsigned v[32];
#pragma unroll
        for (int i = 0; i < 32; ++i) v[i] = __builtin_bit_cast(unsigned, AFF[(size_t)be * SEQ + i * 64 + lane]);
        unsigned thr = 0u;
        for (int bit = 30; bit >= 0; --bit) {
            const unsigned cand = thr | (1u << bit); int c = 0;
#pragma unroll
            for (int i = 0; i < 32; ++i) c += (v[i] >= cand) ? 1 : 0;
#pragma unroll
            for (int o = 1; o < 64; o <<= 1) c += __shfl_xor(c, o);
            if (c >= CAP) thr = cand;
        }
        int cg = 0;
#pragma unroll
        for (int i = 0; i < 32; ++i) cg += (v[i] > thr) ? 1 : 0;
#pragma unroll
        for (int o = 1; o < 64; o <<= 1) cg += __shfl_xor(cg, o);
        const int need = CAP - cg;
        int base = 0, tbase = 0;
        const unsigned long long lt = (1ull << lane) - 1ull;
#pragma unroll
        for (int i = 0; i < 32; ++i) {
            const bool gt = v[i] > thr, eq = v[i] == thr;
            const unsigned long long meq = __ballot(eq);
            const int trank = tbase + __popcll(meq & lt);
            const bool sel = gt || (eq && trank < need);
            const unsigned long long ms = __ballot(sel);
            if (sel) { const int slot = base + __popcll(ms & lt), tok = b * SEQ + i * 64 + lane;
                IDX[be * CAP + slot] = tok; GSEL[be * CAP + slot] = __builtin_bit_cast(float, v[i]); INV[(size_t)tok * NE + e] = slot; }
            base += __popcll(ms); tbase += __popcll(meq);
        }
    }
}
__device__ __forceinline__ void p9_accum(f32x4 (&v)[4], const bf16* Y, int b, int cmine, unsigned long long m, int lane) {
    while (m) {
        const int e = __builtin_ctzll(m); m &= m - 1ull;
        const int c = __builtin_amdgcn_readlane(cmine, e);
        const bf16* yr = Y + ((size_t)(b * NE + e) * CAP + c) * DM;
#pragma unroll
        for (int j = 0; j < 4; ++j) { const unsigned long long y4 = *(const unsigned long long*)(yr + 256 * j + 4 * lane);
            v[j][0] += __builtin_bit_cast(float, (unsigned)(y4 & 0xffffull) << 16); v[j][1] += __builtin_bit_cast(float, (unsigned)((y4 >> 16) & 0xffffull) << 16);
            v[j][2] += __builtin_bit_cast(float, (unsigned)((y4 >> 32) & 0xffffull) << 16); v[j][3] += __builtin_bit_cast(float, (unsigned)(y4 >> 48) << 16); }
    }
}
__device__ __forceinline__ void p9_final(Frame& F, const Args& a) {
    unsigned char* ws = a.ws; float* X1 = a.out; const bf16* Y = (const bf16*)(ws + WS_Y); const int* INV = (const int*)(ws + WS_INV); const float* gfin = a.in[16];
    const int gw = F.vcu * NWAVES + F.wave, NGW = F.G * NWAVES, lane = F.lane;
    f32x4 gv[4];
#pragma unroll
    for (int j = 0; j < 4; ++j) gv[j] = *(const f32x4*)(gfin + 256 * j + 4 * lane);
    for (int row = gw; row < T; row += 2 * NGW) {
        const bool two = (row + NGW < T); const int rowb = two ? row + NGW : row;
        const int ca = (lane < NE) ? INV[(size_t)row * NE + lane] : -1, cb = (lane < NE) ? INV[(size_t)rowb * NE + lane] : -1;
        f32x4 va[4], vb[4];
#pragma unroll
        for (int j = 0; j < 4; ++j) { va[j] = *(const f32x4*)(X1 + (size_t)row * DM + 256 * j + 4 * lane); vb[j] = *(const f32x4*)(X1 + (size_t)rowb * DM + 256 * j + 4 * lane); }
        p9_accum(va, Y, row / SEQ, ca, __ballot(ca >= 0), lane);
        p9_accum(vb, Y, rowb / SEQ, cb, __ballot(cb >= 0), lane);
        float sa = 0.f, sb = 0.f;
#pragma unroll
        for (int j = 0; j < 4; ++j) { sa += (va[j][0] * va[j][0] + va[j][1] * va[j][1]) + (va[j][2] * va[j][2] + va[j][3] * va[j][3]); sb += (vb[j][0] * vb[j][0] + vb[j][1] * vb[j][1]) + (vb[j][2] * vb[j][2] + vb[j][3] * vb[j][3]); }
#pragma unroll
        for (int o = 1; o < 64; o <<= 1) { sa += __shfl_xor(sa, o); sb += __shfl_xor(sb, o); }
        const float ra = rsqrtf(sa * (1.0f / DM) + EPS), rb = rsqrtf(sb * (1.0f / DM) + EPS);
#pragma unroll
        for (int j = 0; j < 4; ++j) *(f32x4*)(X1 + (size_t)row * DM + 256 * j + 4 * lane) = va[j] * ra * gv[j];
        if (two) {
#pragma unroll
            for (int j = 0; j < 4; ++j) *(f32x4*)(X1 + (size_t)rowb * DM + 256 * j + 4 * lane) = vb[j] * rb * gv[j];
        }
    }
}

__global__ void __launch_bounds__(NWAVES * 64, 2) mk_fwd(Args args) {
    extern __shared__ __attribute__((aligned(16))) unsigned char lds[];
    Frame F;
    F.lds = (LAS unsigned char*)lds;
    F.MISC = (volatile LAS unsigned*)(F.lds + MISC_OFF);
    F.tid = threadIdx.x; F.lane = F.tid & 63; F.wave = __builtin_amdgcn_readfirstlane(F.tid >> 6);
    F.G = gridDim.x; { const int bx = blockIdx.x; F.vcu = (F.G % 8 == 0) ? (bx % 8) * (F.G / 8) + bx / 8 : bx; }
    unsigned char* ws = args.ws;
    F.ctl = (gu32*)(ws + WS_CTL);
    for (int u = F.tid; u < (LDS_BYTES - LDSCTL_OFF) / 4; u += NWAVES * 64) ((LAS unsigned*)(F.lds + LDSCTL_OFF))[u] = 0u;
    __syncthreads();
    const int lo = args.ph_lo, hi = args.ph_hi;
    XcdBarrier bar; bar.bar = (unsigned*)(F.ctl + CW_BAR) + args.li * XCD_BAR_WORDS; bar.x = 0; bar.st = nullptr;
    if (hi - lo > 1) bar = xcd_barrier_post((unsigned*)(F.ctl + CW_BAR) + args.li * XCD_BAR_WORDS, F.MISC + 8);
#ifndef DBL
#define DBL 0
#endif
#define IN(k) (lo <= (k) && (k) < hi)
#define REP(k) for (int rep_ = 0; rep_ < 1 + ((DBL >> (k)) & 1); ++rep_)
#define SEAM(k) do { if (IN(k) && IN((k) + 1)) xcd_barrier(bar); } while (0)

    bf16* XN = (bf16*)(ws + WS_XN); bf16* U = (bf16*)(ws + WS_U); bf16* VG = (bf16*)(ws + WS_VG); bf16* Q = (bf16*)(ws + WS_Q); bf16* Kb = (bf16*)(ws + WS_K); bf16* Vb = (bf16*)(ws + WS_V);
    bf16* Win_t = (bf16*)(ws + WS_WIN);
    float* cosT = (float*)(ws + WS_ROPE); float* sinT = cosT + 1024;

    if (IN(0)) { REP(0) p0_prologue(F, args); SEAM(0); }
    if (IN(1)) { REP(1) {
        pg8::Prob<false> g{XN, Win_t, nullptr, DM, 0}; pg8::StaticOrder S; S.init(T, INW, F.G, (int)blockIdx.x);
        EpiInProj E{U, VG, Q, Kb, Vb, args.in[3], args.in[6], args.in[7], cosT, sinT};
        pg8::gemm_phase<EpiInProj, pg8::Prob<false>, pg8::StaticOrder, true>(F.lds + RING_OFF, g, S, E); }
        SEAM(1);
    }
    bf16* A2 = (bf16*)(ws + WS_A2); float* SSB = (float*)(ws + WS_SSB);
    if (IN(2)) { REP(2) {
        static_assert(attn_body::ATTN_LDS_BYTES <= RING_BYTES, "attention LDS");
        const attn_body::AttnTensors AT{(const attn_body::bf16*)Q, (const attn_body::bf16*)Kb, (const attn_body::bf16*)Vb, (attn_body::bf16*)A2, SSB};
        const attn_body::StaticOrder S((int)F.G, F.vcu);
        attn_body::attn_phase<attn_body::StaticOrder>((char*)lds + RING_OFF, AT, S); }
        SEAM(2);
    }
    if (IN(3)) { REP(3) p3_gmlp(F, args); SEAM(3); }
    if (IN(4)) { REP(4) {
        pg8::Prob<false> g{A2, (bf16*)(ws + WS_WOUT), nullptr, DM, 0}; pg8::StaticOrder S; S.init(T, DM, F.G, (int)blockIdx.x);
        EpiOutProj E{args.in[0], SSB, args.out, (bf16*)(ws + WS_X1B)};
        pg8::gemm_phase<EpiOutProj, pg8::Prob<false>, pg8::StaticOrder, true>(F.lds + RING_OFF, g, S, E); }
        SEAM(4);
    }
    if (IN(5)) { REP(5) p5_router(F, args); SEAM(5); }
    if (IN(6)) { REP(6) p6_topk(F, args); SEAM(6); }
    int* IDX = (int*)(ws + WS_IDX); float* GSEL = (float*)(ws + WS_GSEL); float* RS2 = (float*)(ws + WS_RS2); bf16* HH = (bf16*)(ws + WS_HH); bf16* Y = (bf16*)(ws + WS_Y);
    if (IN(7)) { REP(7) {
        pg8::Prob<true> g{(bf16*)(ws + WS_X1B), (bf16*)(ws + WS_WGU), IDX, DM, (size_t)2048 * DM}; pg8::MoeOrder S{F.vcu, F.G, 8};
        EpiGateUp E{IDX, RS2, HH};
        pg8::gemm_phase<EpiGateUp, pg8::Prob<true>, pg8::MoeOrder, true>(F.lds + RING_OFF, g, S, E); }
        SEAM(7);
    }
    if (IN(8)) { REP(8) {
        pg8::Prob<false> g{HH, (bf16*)(ws + WS_WD), nullptr, EFF, (size_t)DM * EFF}; pg8::MoeOrder S{F.vcu, F.G, 4};
        EpiDown E{GSEL, Y};
        pg8::gemm_phase<EpiDown, pg8::Prob<false>, pg8::MoeOrder, true>(F.lds + RING_OFF, g, S, E); }
        SEAM(8);
    }
    if (IN(9)) { p9_final(F, args); }
#undef IN
#undef SEAM
}
__global__ void nv_rope_table(float* rope) {
    const int t = blockIdx.x * blockDim.x + threadIdx.x;
    if (t >= 64 * 16) return;
    const int pos = t / 16, i = t % 16;
    const float inv = powf(10000.0f, -(float)i / 16.0f);
    const float ang = (float)pos * inv;
    rope[2 * t] = cosf(ang); rope[2 * t + 1] = sinf(ang);
}
__global__ void nv_fill_i32(int* p, int v, int n) { const int i = blockIdx.x * blockDim.x + threadIdx.x; if (i < n) p[i] = v; }

__global__ void __launch_bounds__(256) nv_xn(const float* __restrict__ x, bf16* __restrict__ xn) {
    const int row = blockIdx.x * 4 + (threadIdx.x >> 6), lane = threadIdx.x & 63;
    const float* xr = x + (size_t)row * DM;
    float v[16]; float ss = 0.f;
#pragma unroll
    for (int i = 0; i < 16; ++i) { v[i] = xr[i * 64 + lane]; ss += v[i] * v[i]; }
    ss = wave_sum(ss);
    const float rstd = rsqrtf(ss * (1.0f / DM) + EPS);
#pragma unroll
    for (int i = 0; i < 16; ++i) xn[(size_t)row * DM + i * 64 + lane] = (bf16)f2bf(v[i] * rstd);
}

template <int NB, class AL, class BL, class EP>
__global__ void __launch_bounds__(256) nv_gemm(AL al, BL bl, EP ep, int K) {
    __shared__ float As[16][68];
    __shared__ float Bs[NB][16][68];
    __shared__ float Ct[NB][64][65];
    const int tid = threadIdx.x, ty = tid >> 4, tx = tid & 15;
    const int row0 = blockIdx.y * 64, col0 = blockIdx.x * 64;
    float acc[NB][4][4];
#pragma unroll
    for (int b = 0; b < NB; ++b)
#pragma unroll
        for (int i = 0; i < 4; ++i)
#pragma unroll
            for (int j = 0; j < 4; ++j) acc[b][i][j] = 0.f;
    for (int k0 = 0; k0 < K; k0 += 16) {
#pragma unroll
        for (int i = 0; i < 4; ++i) { const int e = tid + i * 256, r = e >> 4, kk = e & 15; As[kk][r] = al(row0 + r, k0 + kk); }
#pragma unroll
        for (int b = 0; b < NB; ++b)
#pragma unroll
            for (int i = 0; i < 4; ++i) { const int e = tid + i * 256, kk = e >> 6, c = e & 63; Bs[b][kk][c] = bl(b, k0 + kk, col0 + c, row0); }
        __syncthreads();
#pragma unroll
        for (int kk = 0; kk < 16; ++kk) {
            float a[4];
#pragma unroll
            for (int i = 0; i < 4; ++i) a[i] = As[kk][ty * 4 + i];
#pragma unroll
            for (int b = 0; b < NB; ++b) {
                float bv[4];
#pragma unroll
                for (int j = 0; j < 4; ++j) bv[j] = Bs[b][kk][tx * 4 + j];
#pragma unroll
                for (int i = 0; i < 4; ++i)
#pragma unroll
                    for (int j = 0; j < 4; ++j) acc[b][i][j] += a[i] * bv[j];
            }
        }
        __syncthreads();
    }
#pragma unroll
    for (int b = 0; b < NB; ++b)
#pragma unroll
        for (int i = 0; i < 4; ++i)
#pragma unroll
            for (int j = 0; j < 4; ++j) Ct[b][ty * 4 + i][tx * 4 + j] = acc[b][i][j];
    __syncthreads();
    ep(Ct, row0, col0, tid);
}

struct AL_bf16 { const bf16* A; int lda; int pad; __device__ float operator()(int r, int k) const { return bf2f(A[(size_t)r * lda + k]); } };
struct BL_win { const float* w; const float* g; __device__ float operator()(int, int k, int c, int) const { return w[(size_t)k * INW + c] * g[k]; } };
struct EP_inproj {
    bf16 *U, *VG, *Q, *Kb, *Vb; const float *gv, *gq, *gk;
    __device__ void operator()(float (*Ct)[64][65], int row0, int col0, int tid) const {
        const int ct = col0 / 64;
        const int r = tid >> 2, seg = tid & 3;
        const int row = row0 + r;
        float v[16];
#pragma unroll
        for (int j = 0; j < 16; ++j) v[j] = Ct[0][r][seg * 16 + j];
        if (ct < 8) {
#pragma unroll
            for (int j = 0; j < 16; ++j) U[(size_t)row * AW + ct * 64 + seg * 16 + j] = (bf16)f2bf(gelu_tanh(v[j]));
        } else if (ct < 16) {
            const int h = ct - 8; float ss = 0.f;
#pragma unroll
            for (int j = 0; j < 16; ++j) { v[j] = gelu_tanh(v[j]); ss += v[j] * v[j]; }
            ss += __shfl_xor(ss, 1); ss += __shfl_xor(ss, 2);
            const float rstd = rsqrtf(ss * (1.0f / 64.0f) + EPS);
#pragma unroll
            for (int j = 0; j < 16; ++j) VG[(size_t)row * AW + h * 64 + seg * 16 + j] = (bf16)f2bf(v[j] * rstd * gv[h * 64 + seg * 16 + j]);
        } else if (ct < 26) {
            const bool isq = ct < 24; const int h = isq ? ct - 16 : ct - 24; const float* g = isq ? gq : gk;
            float ss = 0.f;
#pragma unroll
            for (int j = 0; j < 16; ++j) ss += v[j] * v[j];
            ss += __shfl_xor(ss, 1); ss += __shfl_xor(ss, 2);
            const float rstd = rsqrtf(ss * (1.0f / 64.0f) + EPS);
            const int t = row % SEQ; const int pos = (seg < 2) ? (t / 64) : (t % 64);
#pragma unroll
            for (int j = 0; j < 16; ++j) {
                const int d = seg * 16 + j, pd = (seg ^ 1) * 16 + j;
                const float me = v[j] * rstd * g[d], pa = Ct[0][r][pd] * rstd * g[pd];
                const float inv = powf(10000.0f, -(float)j / 16.0f), ang = (float)pos * inv;
                const float c = cosf(ang), s = sinf(ang);
                const float o = (seg & 1) ? (me * c + pa * s) : (me * c - pa * s);
                if (isq) Q[(size_t)row * BW + h * 64 + d] = (bf16)f2bf(o * QSCALE);
                else Kb[(size_t)row * KVW + h * 64 + d] = (bf16)f2bf(o);
            }
        } else {
            const int h = ct - 26;
#pragma unroll
            for (int j = 0; j < 16; ++j) Vb[(size_t)row * KVW + h * 64 + seg * 16 + j] = (bf16)f2bf(v[j]);
        }
    }
};

__global__ void __launch_bounds__(256) nv_attn(const bf16* __restrict__ Q, const bf16* __restrict__ Kb, const bf16* __restrict__ Vb, bf16* __restrict__ A2, float* __restrict__ SSB) {
    __shared__ float Ks[64][64];
    __shared__ float Vs[64][64];
    const int tid = threadIdx.x, qb = blockIdx.x, hq = blockIdx.y, b = blockIdx.z, hk = hq >> 2;
    const size_t row = (size_t)b * SEQ + qb * 256 + tid;
    float q[64], o[64];
#pragma unroll
    for (int d = 0; d < 64; ++d) { q[d] = bf2f(Q[row * BW + hq * 64 + d]); o[d] = 0.f; }
    float m = -1e30f, l = 0.f;
    for (int kt = 0; kt < SEQ / 64; ++kt) {
        __syncthreads();
#pragma unroll
        for (int i = 0; i < 16; ++i) { const int e = tid + i * 256, key = e >> 6, d = e & 63; const size_t kr = (size_t)b * SEQ + kt * 64 + key;
            Ks[key][d] = bf2f(Kb[kr * KVW + hk * 64 + d]); Vs[key][d] = bf2f(Vb[kr * KVW + hk * 64 + d]); }
        __syncthreads();
        for (int key = 0; key < 64; ++key) {
            float s = 0.f;
#pragma unroll
            for (int d = 0; d < 64; ++d) s += q[d] * Ks[key][d];
            const float mn = fmaxf(m, s), corr = exp2f(m - mn), p = exp2f(s - mn);
            l = l * corr + p; m = mn;
#pragma unroll
            for (int d = 0; d < 64; ++d) o[d] = o[d] * corr + p * Vs[key][d];
        }
    }
    const float il = 1.0f / l; float ss = 0.f;
#pragma unroll
    for (int d = 0; d < 64; ++d) { const float ov = o[d] * il; ss += ov * ov; A2[row * DM + 512 + hq * 64 + d] = (bf16)f2bf(ov); }
    SSB[row * 8 + hq] = ss;
}

__global__ void __launch_bounds__(512) nv_gmlp(const bf16* __restrict__ U, const bf16* __restrict__ VG, const float* __restrict__ ws, const float* __restrict__ bs, const float* __restrict__ SSB, bf16* __restrict__ A2) {
    __shared__ float red[8];
    const int tid = threadIdx.x, h = tid >> 6, d = tid & 63;
    const int row = blockIdx.x, b = row / SEQ, s = row % SEQ, ch = s / CHUNK, p = s % CHUNK;
    const size_t base = (size_t)b * SEQ + ch * CHUNK;
    float gate = bs[h * CHUNK + p];
    const float* wr = ws + ((size_t)h * CHUNK + p) * CHUNK;
    for (int q = 0; q < CHUNK; ++q) gate += wr[q] * bf2f(VG[(base + q) * AW + h * 64 + d]);
    const float a = bf2f(U[(size_t)row * AW + tid]) * gate;
    float ss = wave_sum(a * a);
    if ((tid & 63) == 0) red[h] = ss;
    __syncthreads();
    float tot = 0.f, sb = 0.f;
#pragma unroll
    for (int i = 0; i < 8; ++i) { tot += red[i]; sb += SSB[(size_t)row * 8 + i]; }
    const float rstd_a = rsqrtf(tot * (1.0f / AW) + EPS), rstd_b = rsqrtf(sb * (1.0f / BW) + EPS);
    A2[(size_t)row * DM + tid] = (bf16)f2bf(a * rstd_a / rstd_b);
}

struct BL_wout { const float* w; const float* ga; const float* gb; __device__ float operator()(int, int k, int c, int) const { return w[(size_t)k * DM + c] * (k < 512 ? ga[k] : gb[k - 512]); } };
struct EP_outproj {
    const float* x; const float* SSB; float* X1; bf16* X1B;
    __device__ void operator()(float (*Ct)[64][65], int row0, int col0, int tid) const {
        const int r = tid >> 2, seg = tid & 3; const size_t row = row0 + r;
        float sb = 0.f;
#pragma unroll
        for (int i = 0; i < 8; ++i) sb += SSB[row * 8 + i];
        const float rstd_b = rsqrtf(sb * (1.0f / BW) + EPS);
#pragma unroll
        for (int j = 0; j < 16; ++j) { const int c = col0 + seg * 16 + j; const float v = x[row * DM + c] + rstd_b * Ct[0][r][seg * 16 + j]; X1[row * DM + c] = v; X1B[row * DM + c] = (bf16)f2bf(v); }
    }
};

__global__ void __launch_bounds__(256) nv_router(const float* __restrict__ X1, const float* __restrict__ gf, const float* __restrict__ wr, float* __restrict__ AFF, float* __restrict__ RS2) {
    const int row = blockIdx.x * 4 + (threadIdx.x >> 6), lane = threadIdx.x & 63;
    float lg[16]; float ss = 0.f;
#pragma unroll
    for (int e = 0; e < 16; ++e) lg[e] = 0.f;
#pragma unroll
    for (int i = 0; i < 16; ++i) { const int c = i * 64 + lane; const float xv = X1[(size_t)row * DM + c]; ss += xv * xv; const float hv = xv * gf[c];
#pragma unroll
        for (int e = 0; e < 16; ++e) lg[e] += hv * wr[c * 16 + e]; }
    ss = wave_sum(ss);
    const float rstd = rsqrtf(ss * (1.0f / DM) + EPS);
    float mx = -1e30f;
#pragma unroll
    for (int e = 0; e < 16; ++e) { lg[e] = wave_sum(lg[e]) * rstd; mx = fmaxf(mx, lg[e]); }
    float den = 0.f;
#pragma unroll
    for (int e = 0; e < 16; ++e) { lg[e] = expf(lg[e] - mx); den += lg[e]; }
    const float id = 1.0f / den;
    const int b = row / SEQ, s = row % SEQ;
    float mine = 0.f;
#pragma unroll
    for (int e = 0; e < 16; ++e) if (lane == e) mine = lg[e] * id;
    if (lane < 16) AFF[((size_t)b * NE + lane) * SEQ + s] = mine;
    if (lane == 0) RS2[row] = rstd;
}

__global__ void __launch_bounds__(512) nv_topk(const float* __restrict__ AFF, int* __restrict__ IDX, float* __restrict__ GSEL, int* __restrict__ INV) {
    __shared__ float av[SEQ];
    const int be = blockIdx.x, b = be / NE, e = be % NE, tid = threadIdx.x;
#pragma unroll
    for (int i = 0; i < 4; ++i) av[tid + i * 512] = AFF[(size_t)be * SEQ + tid + i * 512];
    __syncthreads();
#pragma unroll
    for (int i = 0; i < 4; ++i) {
        const int s = tid + i * 512; const float v = av[s]; int rank = 0;
        for (int j = 0; j < SEQ; ++j) { const float w = av[j]; rank += (w > v || (w == v && j < s)) ? 1 : 0; }
        if (rank < CAP) { IDX[be * CAP + rank] = b * SEQ + s; GSEL[be * CAP + rank] = v; INV[((size_t)b * SEQ + s) * NE + e] = rank; }
    }
}

struct AL_gather { const bf16* A; const int* idx; __device__ float operator()(int r, int k) const { return bf2f(A[(size_t)idx[r] * DM + k]); } };
struct BL_gu { const float* wg; const float* wu; const float* g; __device__ float operator()(int b, int k, int c, int row0) const { const int e = (row0 / CAP) % NE; const float* w = b ? wu : wg; return w[((size_t)e * DM + k) * EFF + c] * g[k]; } };
struct EP_gu {
    const int* idx; const float* RS2; bf16* HH;
    __device__ void operator()(float (*Ct)[64][65], int row0, int col0, int tid) const {
        const int r = tid >> 2, seg = tid & 3; const size_t row = row0 + r; const float rs = RS2[idx[row]];
#pragma unroll
        for (int j = 0; j < 16; ++j) { const float a = Ct[0][r][seg * 16 + j] * rs, bb = Ct[1][r][seg * 16 + j] * rs; const float hv = a / (1.0f + expf(-a)) * bb; HH[row * EFF + col0 + seg * 16 + j] = (bf16)f2bf(hv); }
    }
};
struct BL_down { const float* wd; __device__ float operator()(int, int k, int c, int row0) const { const int e = (row0 / CAP) % NE; return wd[((size_t)e * EFF + k) * DM + c]; } };
struct EP_down {
    const float* GSEL; bf16* Y;
    __device__ void operator()(float (*Ct)[64][65], int row0, int col0, int tid) const {
        const int r = tid >> 2, seg = tid & 3; const size_t row = row0 + r; const float g = GSEL[row];
#pragma unroll
        for (int j = 0; j < 16; ++j) Y[row * DM + col0 + seg * 16 + j] = (bf16)f2bf(Ct[0][r][seg * 16 + j] * g);
    }
};

__global__ void __launch_bounds__(256) nv_final(float* __restrict__ X1out, const bf16* __restrict__ Y, const int* __restrict__ INV, const float* __restrict__ gfin) {
    const int row = blockIdx.x * 4 + (threadIdx.x >> 6), lane = threadIdx.x & 63, b = row / SEQ;
    float v[16];
#pragma unroll
    for (int i = 0; i < 16; ++i) v[i] = X1out[(size_t)row * DM + i * 64 + lane];
    for (int e = 0; e < NE; ++e) {
        const int c = INV[(size_t)row * NE + e];
        if (c >= 0) { const bf16* yr = Y + ((size_t)(b * NE + e) * CAP + c) * DM;
#pragma unroll
            for (int i = 0; i < 16; ++i) v[i] += bf2f(yr[i * 64 + lane]); }
    }
    float ss = 0.f;
#pragma unroll
    for (int i = 0; i < 16; ++i) ss += v[i] * v[i];
    ss = wave_sum(ss);
    const float rstd = rsqrtf(ss * (1.0f / DM) + EPS);
#pragma unroll
    for (int i = 0; i < 16; ++i) X1out[(size_t)row * DM + i * 64 + lane] = v[i] * rstd * gfin[i * 64 + lane];
}

#ifndef HYBRID
#define HYBRID 0
#endif
static int g_grid = 0;
static void launch_mk(const Args& base, int lo, int hi, int li, hipStream_t stream) {
    Args a = base; a.ph_lo = lo; a.ph_hi = hi; a.li = li; a.pad = 0;
    void* params[] = {(void*)&a};
    hipError_t e = hipLaunchCooperativeKernel((const void*)mk_fwd, dim3(g_grid), dim3(NWAVES * 64), params, LDS_BYTES, stream);
    if (e != hipSuccess) fprintf(stderr, "kernel_launch: cooperative launch failed: %s (grid %d)\n", hipGetErrorString(e), g_grid);
}
extern "C" void kernel_launch(void* const* d_in, const int* in_sizes, int n_in, void* d_out, int out_size, void* d_ws, size_t ws_size, hipStream_t stream) {
    if (n_in != 17 || in_sizes[0] != T * DM || out_size != T * DM || ws_size < WS_END) { fprintf(stderr, "kernel_launch: unexpected shapes / workspace (%d inputs, ws %zu)\n", n_in, ws_size); return; }
    if (g_grid == 0) {
        int dev = 0, cus = 0, per_cu = 0;
        if (hipGetDevice(&dev) != hipSuccess || hipDeviceGetAttribute(&cus, hipDeviceAttributeMultiprocessorCount, dev) != hipSuccess) { g_grid = -1; return; }
        if (hipFuncSetAttribute((const void*)mk_fwd, hipFuncAttributeMaxDynamicSharedMemorySize, LDS_BYTES) != hipSuccess) { fprintf(stderr, "kernel_launch: hipFuncSetAttribute failed\n"); g_grid = -1; return; }
        if (hipOccupancyMaxActiveBlocksPerMultiprocessor(&per_cu, (const void*)mk_fwd, NWAVES * 64, LDS_BYTES) != hipSuccess || per_cu < 1) { fprintf(stderr, "kernel_launch: occupancy query says %d blocks per CU\n", per_cu); per_cu = 1; }
        (void)hipGetLastError();
        if (per_cu > 1) per_cu = 1;
        g_grid = cus * per_cu;
    }
    if (g_grid < 0) return;
    const float* x = (const float*)d_in[0]; const float* g_mix = (const float*)d_in[1]; const float* w_in = (const float*)d_in[2];
    const float* g_v = (const float*)d_in[3]; const float* w_s = (const float*)d_in[4]; const float* b_s = (const float*)d_in[5];
    const float* g_q = (const float*)d_in[6]; const float* g_k = (const float*)d_in[7]; const float* g_a = (const float*)d_in[8]; const float* g_b = (const float*)d_in[9];
    const float* w_out = (const float*)d_in[10]; const float* g_ffn = (const float*)d_in[11]; const float* w_router = (const float*)d_in[12];
    const float* w_gate = (const float*)d_in[13]; const float* w_up = (const float*)d_in[14]; const float* w_down = (const float*)d_in[15]; const float* g_fin = (const float*)d_in[16];
    unsigned char* ws = (unsigned char*)d_ws; float* out = (float*)d_out;
    float* SSB = (float*)(ws + WS_SSB); float* RS2 = (float*)(ws + WS_RS2); float* AFF = (float*)(ws + WS_AFF);
    int* IDX = (int*)(ws + WS_IDX); float* GSEL = (float*)(ws + WS_GSEL); int* INV = (int*)(ws + WS_INV);
    bf16* X1B = (bf16*)(ws + WS_X1B); bf16* XN = (bf16*)(ws + WS_XN); bf16* U = (bf16*)(ws + WS_U); bf16* VG = (bf16*)(ws + WS_VG);
    bf16* Q = (bf16*)(ws + WS_Q); bf16* Kb = (bf16*)(ws + WS_K); bf16* Vb = (bf16*)(ws + WS_V); bf16* A2 = (bf16*)(ws + WS_A2);
    bf16* HH = (bf16*)(ws + WS_HH); bf16* Y = (bf16*)(ws + WS_Y);
    (void)x; (void)g_mix; (void)w_in; (void)g_v; (void)g_q; (void)g_k; (void)XN; (void)INV;

    (void)hipMemsetAsync((char*)d_ws + WS_CTL, 0, 1 * MiB, stream);
    Args a{};
    for (int i = 0; i < 17; ++i) a.in[i] = (const float*)d_in[i];
    a.out = out; a.ws = ws;
#if HYBRID
    launch_mk(a, 0, 3, 0, stream);
    launch_mk(a, 3, 4, 1, stream);
    launch_mk(a, 4, 5, 1, stream);
    launch_mk(a, 5, 6, 1, stream);
    launch_mk(a, 6, 7, 1, stream);
    launch_mk(a, 7, 9, 2, stream);
    launch_mk(a, 9, 10, 3, stream);
#else
    launch_mk(a, 0, N_PHASES, 0, stream);
#endif
}
```

```cpp
#include <hip/hip_runtime.h>
#include <hip/hip_bf16.h>
#include <cstdint>
#include <cstdio>

constexpr int BATCH = 16, SEQ = 2048, DM = 1024, T = BATCH * SEQ;
constexpr int HD = 64, AH = 8, AW = 512, CHUNK = 128, BH = 8, BKV = 2, BW = 512, KVW = 128, INW = 1792;
constexpr int NE = 16, CAP = 256, EFF = 1024, NSLOT = BATCH * NE * CAP;
constexpr float EPS = 1e-6f;
constexpr float QSCALE = 0.125f * 1.4426950408889634f;

typedef unsigned short bf16;

constexpr size_t MiB = 1u << 20;
constexpr size_t WS_CTL = 0;
constexpr size_t WS_SSB = 1 * MiB;
constexpr size_t WS_RS2 = 2 * MiB;
constexpr size_t WS_AFF = 3 * MiB;
constexpr size_t WS_IDX = 5 * MiB;
constexpr size_t WS_GSEL = 6 * MiB;
constexpr size_t WS_INV = 7 * MiB;
constexpr size_t WS_ROPE = 9 * MiB;
constexpr size_t WS_WIN = 16 * MiB;
constexpr size_t WS_WOUT = 20 * MiB;
constexpr size_t WS_WS = 22 * MiB;
constexpr size_t WS_WGU = 24 * MiB;
constexpr size_t WS_WD = 88 * MiB;
constexpr size_t WS_X1B = 120 * MiB;
constexpr size_t WS_XN = 184 * MiB;
constexpr size_t WS_U = 248 * MiB;
constexpr size_t WS_VG = 280 * MiB;
constexpr size_t WS_Q = 312 * MiB;
constexpr size_t WS_K = 344 * MiB;
constexpr size_t WS_V = 352 * MiB;
constexpr size_t WS_A2 = 360 * MiB;
constexpr size_t WS_HH = 184 * MiB;
constexpr size_t WS_Y = 312 * MiB;
constexpr size_t WS_END = 440 * MiB;

__device__ __forceinline__ unsigned f2bf(float f) { unsigned u = __builtin_bit_cast(unsigned, f); return (u + 0x7fffu + ((u >> 16) & 1u)) >> 16; }
__device__ __forceinline__ float bf2f(bf16 h) { return __builtin_bit_cast(float, (unsigned)h << 16); }
__device__ __forceinline__ float gelu_tanh(float x) { return 0.5f * x * (1.0f + tanhf(0.7978845608028654f * (x + 0.044715f * x * x * x))); }
__device__ __forceinline__ float wave_sum(float v) {
#pragma unroll
    for (int o = 1; o < 64; o <<= 1) v += __shfl_xor(v, o);
    return v;
}

namespace pg8 {
#define PG8_LAS __attribute__((address_space(3)))
typedef unsigned short bf16_t;
typedef short bf16x8 __attribute__((ext_vector_type(8)));
typedef float f32x4 __attribute__((ext_vector_type(4)));
typedef unsigned u32x4 __attribute__((ext_vector_type(4)));
typedef unsigned u32x2 __attribute__((ext_vector_type(2)));
constexpr int BM = 256, BK = 64, HALF = 128, HTB = HALF * BK * 2  , STAGE_BYTES = 8 * HTB, NXCD = 8, WGM = 8;

__host__ __device__ __forceinline__ int lds_byte(int r, int c) { const int st = (r >> 4) * 2 + (c >> 5), rr = r & 15, cc = c & 31, ob = rr * 64 + cc * 2; return st * 1024 + (ob ^ (((ob >> 9) & 1) << 5)); }
__host__ __device__ __forceinline__ void stage_rc(int b, int& R, int& C) { const int st = b / 1024, sb = b % 1024, swz = sb ^ (((sb >> 9) & 1) << 5); R = (st >> 1) * 16 + swz / 64; C = (st & 1) * 32 + (swz % 64) / 2; }
__host__ __device__ __forceinline__ int perm32(int rho) { const int n = rho >> 4, i = rho & 15; return 8 * (i >> 2) + 4 * n + (i & 3); }

struct Unit { int pm, pn; };

struct StaticOrder {
    int nM, nN, nwg, G, c;
    __host__ __device__ void init(int M, int N, int G_, int c_) { nM = M / BM; nN = N / BM; nwg = nM * nN; G = G_; c = c_; }
    __host__ __device__ bool next(int i, Unit& u) const {
        const long L = (long)i * G + c; if (L >= nwg) return false;
        int wgid = (int)L; { const int q = nwg / NXCD, r = nwg % NXCD, xcd = wgid % NXCD, off = wgid / NXCD; wgid = (xcd < r ? xcd * (q + 1) : r * (q + 1) + (xcd - r) * q) + off; }
        const int nig = WGM * nN, gid = wgid / nig, fm = gid * WGM, gsz = (nM - fm) < WGM ? (nM - fm) : WGM;
        u.pm = fm + ((wgid % nig) % gsz); u.pn = (wgid % nig) / gsz; return true;
    }
};
struct MoeOrder {
    int vcu, G, npn;
    __device__ bool next(int i, Unit& u) const {
        if (G == 256) { if (i >= npn) return false; const int xcd = vcu >> 5, l = vcu & 31, idx = i * 32 + l, per = 16 * npn, ei = idx / per, rem = idx % per;
            u.pm = (rem / npn) * 16 + xcd + 8 * ei; u.pn = rem % npn; return true; }
        const long L = (long)i * G + vcu; if (L >= 256L * npn) return false; u.pm = (int)(L / npn); u.pn = (int)(L % npn); return true;
    }
};

__device__ __forceinline__ unsigned cvt_pk_bf16(float lo, float hi) { unsigned r; asm volatile("v_cvt_pk_bf16_f32 %0, %1, %2" : "=v"(r) : "v"(lo), "v"(hi)); return r; }

template <bool GATHER_> struct Prob {
    static constexpr bool GATHER = GATHER_;
    const bf16_t* A; const bf16_t* Bt; const int* idx; int K; size_t estride;
    __device__ __forceinline__ const char* a_base(const Unit& u) const { return GATHER ? (const char*)A : (const char*)(A + (size_t)u.pm * BM * K); }
    __device__ __forceinline__ const char* b_base(const Unit& u) const { return (const char*)(Bt + (size_t)(u.pm & 15) * estride + (size_t)u.pn * BM * K); }
    __device__ __forceinline__ unsigned a_row(const Unit& u, int r) const { return (unsigned)idx[u.pm * BM + r]; }
};

template <class Epi, class PB, class Sched, bool ALIGN_EPI>
__device__ __forceinline__ void gemm_phase(PG8_LAS unsigned char* lds, const PB g, const Sched& S, const Epi& E) {
    const int tid = threadIdx.x, wid = __builtin_amdgcn_readfirstlane(tid >> 6), lane = tid & 63, wr = wid >> 2, wc = wid & 3, fr = lane & 15, fq = lane >> 4;
    const int K = g.K, nt = K / BK;
    unsigned voffA[2], voffB[2]; int RA[2], CA2[2];
#pragma unroll
    for (int i = 0; i < 2; ++i) { int R, C; stage_rc(tid * 16 + i * 8192, R, C); const int Rb = Epi::PERM ? ((R & ~31) + perm32(R & 31)) : R;
        voffA[i] = (unsigned)(R * K + C) * 2u; voffB[i] = (unsigned)(Rb * K + C) * 2u; RA[i] = R; CA2[i] = C * 2; }
    const size_t kstep = (size_t)(BK * 2);
    const size_t hstep = (size_t)HALF * K * 2;
    const unsigned ldsw = (unsigned)wid * 1024u;
    const int aoff = lds_byte(wr * 64 + fr, fq * 8), boff = lds_byte(wc * 32 + fr, fq * 8);
#define PG8_SA(b, h) (((b) * 2 + (h)) * HTB)
#define PG8_SB(b, h) ((4 + (b) * 2 + (h)) * HTB)
#define PG8_STAGE(bufoff, gbase, voff) do { _Pragma("unroll") for (int _i = 0; _i < 2; ++_i) \
        __builtin_amdgcn_global_load_lds((const unsigned*)((const char*)(gbase) + (voff)[_i]), (PG8_LAS unsigned*)(lds + (bufoff) + ldsw + _i * 8192), 16, 0, 0); } while (0)
#define PG8_STAGE_A(bufoff, gptr, h, VG) do { if constexpr (PB::GATHER) { PG8_STAGE(bufoff, gptr, VG[h]); } else { PG8_STAGE(bufoff, (gptr) + (h) * hstep, voffA); } } while (0)
#define PG8_LDA(dst, b, h) do { _Pragma("unroll") for (int m = 0; m < 4; ++m) _Pragma("unroll") for (int k = 0; k < 2; ++k) dst[m][k] = *(const PG8_LAS bf16x8*)(lds + PG8_SA(b, h) + aoff + m * 2048 + k * 1024); } while (0)
#define PG8_LDB(dst, b, h) do { _Pragma("unroll") for (int n = 0; n < 2; ++n) _Pragma("unroll") for (int k = 0; k < 2; ++k) dst[n][k] = *(const PG8_LAS bf16x8*)(lds + PG8_SB(b, h) + boff + n * 2048 + k * 1024); } while (0)
#define PG8_MMA(ai, bj, At, Bt) do { __builtin_amdgcn_s_setprio(1); _Pragma("unroll") for (int m = 0; m < 4; ++m) _Pragma("unroll") for (int n = 0; n < 2; ++n) _Pragma("unroll") for (int k = 0; k < 2; ++k) \
        acc[ai][bj][m][n] = __builtin_amdgcn_mfma_f32_16x16x32_bf16(Bt[n][k], At[m][k], acc[ai][bj][m][n], 0, 0, 0); __builtin_amdgcn_s_setprio(0); } while (0)
#define PG8_WAIT_V(n) asm volatile("s_waitcnt vmcnt(" #n ")" ::: "memory")
#define PG8_WAIT_L(n) asm volatile("s_waitcnt lgkmcnt(" #n ")" ::: "memory")
#define PG8_BAR __builtin_amdgcn_s_barrier()
#define PG8_SCHED __builtin_amdgcn_sched_barrier(0)
    Unit cur, nxt; int ui = 0;
    if (!S.next(0, cur)) return;
    f32x4 acc[2][2][4][2];
#pragma unroll
    for (int a = 0; a < 2; ++a)
#pragma unroll
        for (int b = 0; b < 2; ++b)
#pragma unroll
            for (int m = 0; m < 4; ++m)
#pragma unroll
                for (int n = 0; n < 2; ++n) acc[a][b][m][n] = (f32x4){0.f, 0.f, 0.f, 0.f};
    bf16x8 At[4][2], B0[2][2], B1[2][2];
    const char* cA = g.a_base(cur); const char* cB = g.b_base(cur);
    unsigned vGc[2][2], vGx[2][2];
    if constexpr (PB::GATHER) {
#pragma unroll
        for (int h = 0; h < 2; ++h)
#pragma unroll
            for (int i = 0; i < 2; ++i) { vGc[h][i] = g.a_row(cur, h * HALF + RA[i]) * (unsigned)(K * 2) + (unsigned)CA2[i]; vGx[h][i] = vGc[h][i]; }
        asm volatile("s_waitcnt vmcnt(0)" ::: "memory");
    }
    PG8_STAGE(PG8_SB(0, 0), cB, voffB); PG8_STAGE(PG8_SB(0, 1), cB + hstep, voffB); PG8_STAGE_A(PG8_SA(0, 0), cA, 0, vGc); PG8_STAGE_A(PG8_SA(0, 1), cA, 1, vGc);
    if (wr == 1) PG8_BAR;
    PG8_WAIT_V(2); PG8_BAR;
    PG8_STAGE(PG8_SB(1, 0), cB + kstep, voffB); PG8_STAGE_A(PG8_SA(1, 0), cA + kstep, 0, vGc); PG8_STAGE(PG8_SB(1, 1), cB + hstep + kstep, voffB);
    PG8_WAIT_V(6); PG8_BAR;
    for (;;) {
        const bool has_next = S.next(ui + 1, nxt);
        const char* nA = has_next ? g.a_base(nxt) : cA; const char* nB = has_next ? g.b_base(nxt) : cB;
        for (int t = 0; t < nt; t += 2) {
            const bool last = (t == nt - 2);
            const char* a1 = cA + (size_t)(t + 1) * kstep;
            const char* a2 = last ? nA : cA + (size_t)(t + 2) * kstep; const char* b2 = last ? nB : cB + (size_t)(t + 2) * kstep;
            const char* a3 = a2 + kstep; const char* b3 = b2 + kstep;
            if constexpr (PB::GATHER) {
                if (last && has_next) {
#pragma unroll
                    for (int h = 0; h < 2; ++h)
#pragma unroll
                        for (int i = 0; i < 2; ++i) vGx[h][i] = g.a_row(nxt, h * HALF + RA[i]) * (unsigned)(K * 2) + (unsigned)CA2[i];
                }
            }
            PG8_LDB(B0, 0, 0); PG8_LDB(B1, 0, 1); PG8_SCHED; PG8_LDA(At, 0, 0); PG8_STAGE_A(PG8_SA(1, 1), a1, 1, vGc);
            PG8_WAIT_V(8); PG8_WAIT_L(0); PG8_BAR; PG8_MMA(0, 0, At, B0); PG8_MMA(0, 1, At, B1); PG8_BAR; PG8_SCHED;
            PG8_LDA(At, 0, 1); PG8_STAGE(PG8_SB(0, 0), b2, voffB); PG8_STAGE(PG8_SB(0, 1), b2 + hstep, voffB); PG8_STAGE_A(PG8_SA(0, 0), a2, 0, vGx);
            PG8_WAIT_V(8); PG8_WAIT_L(0); PG8_BAR; PG8_MMA(1, 0, At, B0); PG8_MMA(1, 1, At, B1); PG8_BAR; PG8_SCHED;
            PG8_LDB(B0, 1, 0); PG8_LDB(B1, 1, 1); PG8_SCHED; PG8_LDA(At, 1, 0); PG8_STAGE_A(PG8_SA(0, 1), a2, 1, vGx);
            PG8_WAIT_V(8); PG8_WAIT_L(0); PG8_BAR; PG8_MMA(0, 0, At, B0); PG8_MMA(0, 1, At, B1); PG8_BAR; PG8_SCHED;
            PG8_LDA(At, 1, 1); PG8_STAGE(PG8_SB(1, 0), b3, voffB); PG8_STAGE(PG8_SB(1, 1), b3 + hstep, voffB); PG8_STAGE_A(PG8_SA(1, 0), a3, 0, vGx);
            PG8_WAIT_V(8); PG8_WAIT_L(0); PG8_BAR; PG8_MMA(1, 0, At, B0); PG8_MMA(1, 1, At, B1); PG8_BAR; PG8_SCHED;
        }
        if constexpr (ALIGN_EPI) { if (wr == 0) PG8_BAR; }
        E(acc, cur, wr, wc, fr, fq);
        if (!has_next) break;
#pragma unroll
        for (int a = 0; a < 2; ++a)
#pragma unroll
            for (int b = 0; b < 2; ++b)
#pragma unroll
                for (int m = 0; m < 4; ++m)
#pragma unroll
                    for (int n = 0; n < 2; ++n) acc[a][b][m][n] = (f32x4){0.f, 0.f, 0.f, 0.f};
        cur = nxt; cA = nA; cB = nB; ++ui;
        if constexpr (PB::GATHER) {
#pragma unroll
            for (int h = 0; h < 2; ++h)
#pragma unroll
                for (int i = 0; i < 2; ++i) vGc[h][i] = vGx[h][i];
        }
        if constexpr (ALIGN_EPI) { if (wr == 1) PG8_BAR; }
    }
    PG8_WAIT_V(0);
    if constexpr (!ALIGN_EPI) { if (wr == 0) PG8_BAR; }
    PG8_BAR;
#undef PG8_SA
#undef PG8_SB
#undef PG8_STAGE
#undef PG8_STAGE_A
#undef PG8_LDA
#undef PG8_LDB
#undef PG8_MMA
#undef PG8_WAIT_V
#undef PG8_WAIT_L
#undef PG8_BAR
#undef PG8_SCHED
}
}
namespace attn_body {
using bf16=__hip_bfloat16;
using bf16x8=__attribute__((ext_vector_type(8)))short;
using s16x4=__attribute__((ext_vector_type(4)))short;
using f32x16=__attribute__((ext_vector_type(16)))float;
using u32x4=__attribute__((ext_vector_type(4)))unsigned;
constexpr int BATCH=16,NHEAD=8,NKV=2,SEQ=2048,D=64,QP=512,KP=128,OP=1024,OCOL=512;
constexpr int NW=8,QBLK=32,QB=QBLK*NW,KVBLK=64,NQB=SEQ/QB;
constexpr int ATTN_UNIT_ROWS=QB;
__device__ __forceinline__ int crow(int r,int hi){return (r&3)+8*(r>>2)+4*hi;}
#define SBAR() __builtin_amdgcn_sched_barrier(0)
__device__ __forceinline__ void cmask(f32x16&p0,f32x16&p1,int jb,int qrel,int hi){
  const float NEG=-INFINITY; int kb=64*jb+4*hi;
  #pragma unroll
  for(int r=0;r<16;++r){int kv=kb+(r&3)+8*(r>>2); if(kv>qrel)p0[r]=NEG; if(kv+32>qrel)p1[r]=NEG;}
}

constexpr int NSLOT=3, SLOTB=8192;
constexpr int LDS_K=0, LDS_V=NSLOT*SLOTB, LDS_WS=2*NSLOT*SLOTB, LDS_OST=LDS_WS+NW*64*4, LDS_BYTES=LDS_OST+NW*4096;
constexpr float C2=0.125f*1.4426950408889634f;
__device__ __forceinline__ void glds16(const void*gsrc,unsigned lds_dst){unsigned keep;
  asm volatile("s_mov_b32 %0, m0\n\ts_mov_b32 m0, %2\n\ts_nop 0\n\tglobal_load_lds_dwordx4 %1, off\n\ts_mov_b32 m0, %0":"=&s"(keep):"v"(gsrc),"s"(lds_dst):"memory");}
__device__ __forceinline__ float max3f(float a,float b,float c){float r;asm("v_max3_f32 %0, %1, %2, %3":"=v"(r):"v"(a),"v"(b),"v"(c));return r;}
__device__ __forceinline__ float max2f(float a,float b){float r;asm("v_max_f32_e32 %0, %1, %2":"=v"(r):"v"(a),"v"(b));return r;}
__device__ __forceinline__ float fadd_s(float a,float b){float r;asm("v_add_f32_e32 %0, %1, %2":"=v"(r):"v"(a),"v"(b));return r;}
__device__ __forceinline__ float fsub_s(float a,float b){float r;asm("v_sub_f32_e32 %0, %1, %2":"=v"(r):"v"(a),"v"(b));return r;}
typedef float f32x2_t __attribute__((ext_vector_type(2))); typedef __bf16 bf16x2_t __attribute__((ext_vector_type(2)));
__device__ __forceinline__ unsigned cvtpk_s(float lo,float hi){f32x2_t v={lo,hi};bf16x2_t b=__builtin_convertvector(v,bf16x2_t);return __builtin_bit_cast(unsigned,b);}
#define WAIT_BAR(N) asm volatile("s_waitcnt vmcnt(" #N ") lgkmcnt(0)\n\ts_barrier":::"memory")

__device__ __forceinline__ void qkt(f32x16&p0,f32x16&p1,const char*Kslot,const bf16x8*qr,const f32x16&negm,int r32,int hi){
  const char*kb=Kslot+hi*1024+r32*16;
  #pragma unroll
  for(int d0=0;d0<4;++d0){
    const bf16x8 b0=*reinterpret_cast<const bf16x8*>(kb+d0*2048);
    const bf16x8 b1=*reinterpret_cast<const bf16x8*>(kb+d0*2048+512);
    if(d0==0){p0=__builtin_amdgcn_mfma_f32_32x32x16_bf16(b0,qr[0],negm,0,0,0);p1=__builtin_amdgcn_mfma_f32_32x32x16_bf16(b1,qr[0],negm,0,0,0);}
    else{p0=__builtin_amdgcn_mfma_f32_32x32x16_bf16(b0,qr[d0],p0,0,0,0);p1=__builtin_amdgcn_mfma_f32_32x32x16_bf16(b1,qr[d0],p1,0,0,0);}}
}
typedef __attribute__((address_space(3))) const char* lds_cptr;
typedef short v4i16_t __attribute__((ext_vector_type(4)));
__device__ __forceinline__ void kload8(bf16x8*kf,lds_cptr kp){
  kf[0]=*(const __attribute__((address_space(3))) bf16x8*)(kp);      kf[1]=*(const __attribute__((address_space(3))) bf16x8*)(kp+512);
  kf[2]=*(const __attribute__((address_space(3))) bf16x8*)(kp+2048); kf[3]=*(const __attribute__((address_space(3))) bf16x8*)(kp+2560);
  kf[4]=*(const __attribute__((address_space(3))) bf16x8*)(kp+4096); kf[5]=*(const __attribute__((address_space(3))) bf16x8*)(kp+4608);
  kf[6]=*(const __attribute__((address_space(3))) bf16x8*)(kp+6144); kf[7]=*(const __attribute__((address_space(3))) bf16x8*)(kp+6656);
}
__device__ __forceinline__ void kload2(bf16x8*kf,lds_cptr kp,int j){ kf[2*j]=*(const __attribute__((address_space(3))) bf16x8*)(kp+j*2048); kf[2*j+1]=*(const __attribute__((address_space(3))) bf16x8*)(kp+j*2048+512); }
__device__ __forceinline__ s16x4 vtr(lds_cptr p){ return __builtin_bit_cast(s16x4,__builtin_amdgcn_ds_read_tr16_b64_v4i16((__attribute__((address_space(3))) v4i16_t*)p)); }
__device__ __forceinline__ float rowmax(const f32x16&p0,const f32x16&p1){
  float a=max3f(p0[0],p0[1],p1[0]),b=max3f(p0[2],p0[3],p1[1]);a=max3f(a,p1[2],p1[3]);
  #pragma unroll
  for(int r=4;r<16;r+=4){a=max3f(a,p0[r],p0[r+1]);b=max3f(b,p0[r+2],p0[r+3]);a=max3f(a,p1[r],p1[r+1]);b=max3f(b,p1[r+2],p1[r+3]);}
  const float m=max2f(a,b);
  auto rr=__builtin_amdgcn_permlane32_swap(__float_as_uint(m),__float_as_uint(m),false,false);
  return max2f(__uint_as_float(rr[0]),__uint_as_float(rr[1]));
}
__device__ __forceinline__ void pv(f32x16*o,int vb,bf16x8 pa0,bf16x8 pa1,bf16x8 pa2,bf16x8 pa3){
  #pragma unroll
  for(int d0=0;d0<2;++d0){s16x4 lo[4],hi[4];
    #pragma unroll
    for(int ks=0;ks<4;++ks){
      asm volatile("ds_read_b64_tr_b16 %0,%1 offset:%c2":"=&v"(lo[ks]):"v"(vb),"i"(d0*4096+ks*1024):"memory");
      asm volatile("ds_read_b64_tr_b16 %0,%1 offset:%c2":"=&v"(hi[ks]):"v"(vb),"i"(d0*4096+ks*1024+512):"memory");}
    asm volatile("s_waitcnt lgkmcnt(0)":::"memory");SBAR();
    #define PK(k) (bf16x8){lo[k][0],lo[k][1],lo[k][2],lo[k][3],hi[k][0],hi[k][1],hi[k][2],hi[k][3]}
    o[d0]=__builtin_amdgcn_mfma_f32_32x32x16_bf16(pa0,PK(0),o[d0],0,0,0);
    o[d0]=__builtin_amdgcn_mfma_f32_32x32x16_bf16(pa1,PK(1),o[d0],0,0,0);
    o[d0]=__builtin_amdgcn_mfma_f32_32x32x16_bf16(pa2,PK(2),o[d0],0,0,0);
    o[d0]=__builtin_amdgcn_mfma_f32_32x32x16_bf16(pa3,PK(3),o[d0],0,0,0);
    #undef PK
  }
}

#ifndef ATTN_STORE16
#define ATTN_STORE16(p,v) (*(u32x4*)(p)=(v))
#endif
template<int THRL> __device__ __forceinline__ void attn_unit(int b,int h,int qb,const bf16*Q,const bf16*__restrict__ K,const bf16*__restrict__ V,bf16*O,float*SSB,char*shm){
  const int tid=threadIdx.x,lane=tid&63,r32=lane&31,hi=lane>>5; const int wid=__builtin_amdgcn_readfirstlane(tid>>6);
  const long rowbase=(long)b*SEQ; const int q0=qb*QB;
  const int hk=h>>2;
  const bf16*Qw=Q+(rowbase+q0+wid*QBLK)*QP+h*D;
  const bf16*Kh=K+rowbase*KP+hk*D,*Vh=V+rowbase*KP+hk*D;
  const unsigned lds0=(unsigned)(uintptr_t)shm;
  float*wsf=(float*)(shm+LDS_WS)+wid*64;
  const bf16*ksrc=Kh+(long)lane*KP+wid*8;
  const bf16*vsrc=Vh+(long)(16*(wid&3)+(lane>>2))*KP+(wid>>2)*32+(lane&3)*8;
  const unsigned kdst=lds0+LDS_K+wid*1024, vdst=lds0+LDS_V+wid*1024;
  #define DMA_K(t,slot) glds16(ksrc+(long)(t)*KVBLK*KP,(unsigned)__builtin_amdgcn_readfirstlane(kdst+(slot)))
  #define DMA_V(t,slot) glds16(vsrc+(long)(t)*KVBLK*KP,(unsigned)__builtin_amdgcn_readfirstlane(vdst+(slot)))
  const int vb0=(int)(lds0+LDS_V)+((lane>>4)&1)*32+(lane&3)*8+(4*hi+((lane&15)>>2))*64;
  const char*Kbase=shm+LDS_K; bf16x8 kf[8];
  const lds_cptr shm3=(lds_cptr)shm; const lds_cptr kp0=shm3+LDS_K+hi*1024+r32*16; const lds_cptr vp0=shm3+LDS_V+((lane>>4)&1)*32+(lane&3)*8+(4*hi+((lane&15)>>2))*64;
  const int NT=SEQ/KVBLK;
  DMA_K(0,0);DMA_V(0,0);DMA_K(1,SLOTB);
  bf16x8 qr[4];
  #pragma unroll
  for(int d0=0;d0<4;++d0)qr[d0]=*reinterpret_cast<const bf16x8*>(&Qw[(long)r32*QP+d0*16+hi*8]);
  float mhat=0.f,l_reg=0.f;f32x16 o[2];o[0]=f32x16{};o[1]=f32x16{};f32x16 negm=f32x16{};asm volatile("":"+v"(negm));
  #define CMASK(P0,P1,t) do{}while(0)
  bool resc=false;
  #define START(P0,P1) do{ const float rm=rowmax(P0,P1); resc=false; \
    { const float dl=rm; mhat=fadd_s(mhat,dl); \
      _Pragma("unroll") for(int r=0;r<16;++r){P0[r]=fsub_s(P0[r],dl);P1[r]=fsub_s(P1[r],dl);} \
      _Pragma("unroll") for(int r=0;r<16;++r)negm[r]=-mhat; asm volatile("":"+v"(negm)); } \
    _Pragma("unroll") for(int r=0;r<16;++r)P0[r]=__builtin_amdgcn_exp2f(P0[r]); }while(0)
  #define RESC() do{ if(resc){ asm volatile("s_waitcnt lgkmcnt(0)":::"memory"); \
      _Pragma("unroll") for(int d_=0;d_<2;++d_) _Pragma("unroll") for(int r=0;r<16;++r)o[d_][r]*=wsf[crow(r,hi)]; } }while(0)
  f32x16 pA0,pA1,pB0,pB1;
  int sl_prev=0,sl_cur=0,sl_next=SLOTB;
  #define ROT() do{sl_prev=sl_cur;sl_cur=sl_next;sl_next=(sl_next==(NSLOT-1)*SLOTB)?0:sl_next+SLOTB;}while(0)
  DMA_K(2,2*SLOTB);
  WAIT_BAR(3);
  qkt(pA0,pA1,Kbase,qr,negm,r32,hi);asm volatile("s_nop 15\n\ts_nop 7":"+v"(pA0),"+v"(pA1));CMASK(pA0,pA1,0);
  START(pA0,pA1);
  _Pragma("unroll") for(int r=0;r<16;++r)pA1[r]=__builtin_amdgcn_exp2f(pA1[r]);
  WAIT_BAR(0);
  DMA_K(3,0);DMA_V(1,SLOTB);
  ROT();
  kload8(kf,kp0+sl_cur);
  WAIT_BAR(2);
  s16x4 vlo[8],vhi[8]; u32x4 pw0,pw1,pw2,pw3;
  #define PKW(P,B) cvtpk_s(P[B],P[B+1])
  #define PAF(k) __builtin_bit_cast(bf16x8,pw##k)
  #define VFR(i) (bf16x8){vlo[i][0],vlo[i][1],vlo[i][2],vlo[i][3],vhi[i][0],vhi[i][1],vhi[i][2],vhi[i][3]}
  #define PIN(x) asm volatile("":"+v"(x))
  #define MX3(a,b,c) __builtin_fmaxf(__builtin_fmaxf((a),(b)),(c))
  #define GAPA(MF,A0,A1,A2,A3,W0,W1,PW) do{ MF; sacc+=A0; sacc+=A1; sacc+=A2; sacc+=A3; PIN(sacc); W0; W1; PIN(PW); SBAR(); }while(0)
  #define EX(v) __builtin_amdgcn_exp2f(v)
  #define GAPB(MF,X,B) do{ MF; X[B]=EX(X[B]); X[B+1]=EX(X[B+1]); X[B+2]=EX(X[B+2]); X[B+3]=EX(X[B+3]); PIN(X); SBAR(); }while(0)
  #define VRD(i) do{ vlo[i]=vtr(vp_+(((i)>>2)*4096+((i)&3)*1024)); vhi[i]=vtr(vp_+(((i)>>2)*4096+((i)&3)*1024+512)); }while(0)
  #define KRD(G,j) do{ if(G){ kload2(kf,kp0+sl_next,j); SBAR(); } }while(0)
  #define STEP(C0,C1,P0,P1,t,GK,GV,GL) do{ SBAR(); \
    const lds_cptr vp_=vp0+sl_prev; \
    VRD(0); SBAR(); float sacc=(P0[0]+P0[1]); \
    GAPA(C0=__builtin_amdgcn_mfma_f32_32x32x16_bf16(kf[0],qr[0],negm,0,0,0), P0[2],P0[3],P0[4],P0[5],     pw0[0]=PKW(P0,0), pw0[1]=PKW(P0,2), pw0); \
    VRD(4); SBAR(); GAPA(C1=__builtin_amdgcn_mfma_f32_32x32x16_bf16(kf[1],qr[0],negm,0,0,0), P0[6],P0[7],P0[8],P0[9],     pw0[2]=PKW(P0,4), pw0[3]=PKW(P0,6), pw0); \
    VRD(1); SBAR(); GAPA(C0=__builtin_amdgcn_mfma_f32_32x32x16_bf16(kf[2],qr[1],C0,0,0,0),   P0[10],P0[11],P0[12],P0[13], pw1[0]=PKW(P0,8), pw1[1]=PKW(P0,10), pw1); \
    VRD(5); SBAR(); GAPA(C1=__builtin_amdgcn_mfma_f32_32x32x16_bf16(kf[3],qr[1],C1,0,0,0),   P0[14],P0[15],P1[0],P1[1],   pw1[2]=PKW(P0,12),pw1[3]=PKW(P0,14), pw1); \
    VRD(2); SBAR(); GAPA(C0=__builtin_amdgcn_mfma_f32_32x32x16_bf16(kf[4],qr[2],C0,0,0,0),   P1[2],P1[3],P1[4],P1[5],     pw2[0]=PKW(P1,0), pw2[1]=PKW(P1,2), pw2); \
    VRD(6); SBAR(); GAPA(C1=__builtin_amdgcn_mfma_f32_32x32x16_bf16(kf[5],qr[2],C1,0,0,0),   P1[6],P1[7],P1[8],P1[9],     pw2[2]=PKW(P1,4), pw2[3]=PKW(P1,6), pw2); \
    VRD(3); SBAR(); GAPA(C0=__builtin_amdgcn_mfma_f32_32x32x16_bf16(kf[6],qr[3],C0,0,0,0),   P1[10],P1[11],P1[12],P1[13], pw3[0]=PKW(P1,8), pw3[1]=PKW(P1,10), pw3); \
    VRD(7); SBAR(); GAPA(C1=__builtin_amdgcn_mfma_f32_32x32x16_bf16(kf[7],qr[3],C1,0,0,0),   P1[14],P1[15],0.f,0.f,       pw3[2]=PKW(P1,12),pw3[3]=PKW(P1,14), pw3); \
    l_reg+=sacc; \
    if(GK){DMA_K((t)+3,sl_cur);} if(GV){DMA_V((t)+1,sl_next);} \
    CMASK(C0,C1,t); \
    { float a=MX3(C0[0],C0[1],C1[0]),b=MX3(C0[2],C0[3],C1[1]); a=MX3(a,C1[2],C1[3]); \
      _Pragma("unroll") for(int r=4;r<16;r+=4){a=MX3(a,C0[r],C0[r+1]);b=MX3(b,C0[r+2],C0[r+3]);a=MX3(a,C1[r],C1[r+1]);b=MX3(b,C1[r+2],C1[r+3]);} \
      float rm=__builtin_fmaxf(a,b); { auto rr=__builtin_amdgcn_permlane32_swap(__float_as_uint(rm),__float_as_uint(rm),false,false); rm=__builtin_fmaxf(__uint_as_float(rr[0]),__uint_as_float(rr[1])); } \
      resc=false; \
      if(__builtin_expect(__any(rm>(float)THRL),0)){ const float dl=__builtin_fmaxf(rm,0.f); mhat+=dl; \
        _Pragma("unroll") for(int r=0;r<16;++r){C0[r]-=dl;C1[r]-=dl;} \
        _Pragma("unroll") for(int r=0;r<16;++r)negm[r]=-mhat; asm volatile("":"+v"(negm)); \
        const float f=__builtin_amdgcn_exp2f(-dl); l_reg*=f; if(hi==0)wsf[r32]=f; resc=true; } } \
    SBAR(); \
    GAPB(o[0]=__builtin_amdgcn_mfma_f32_32x32x16_bf16(PAF(0),VFR(0),o[0],0,0,0), C0,0); \
    GAPB(o[1]=__builtin_amdgcn_mfma_f32_32x32x16_bf16(PAF(0),VFR(4),o[1],0,0,0), C0,4); \
    KRD(GL,0); GAPB(o[0]=__builtin_amdgcn_mfma_f32_32x32x16_bf16(PAF(1),VFR(1),o[0],0,0,0), C0,8); \
    KRD(GL,1); GAPB(o[1]=__builtin_amdgcn_mfma_f32_32x32x16_bf16(PAF(1),VFR(5),o[1],0,0,0), C0,12); \
    KRD(GL,2); GAPB(o[0]=__builtin_amdgcn_mfma_f32_32x32x16_bf16(PAF(2),VFR(2),o[0],0,0,0), C1,0); \
    KRD(GL,3); GAPB(o[1]=__builtin_amdgcn_mfma_f32_32x32x16_bf16(PAF(2),VFR(6),o[1],0,0,0), C1,4); \
    GAPB(o[0]=__builtin_amdgcn_mfma_f32_32x32x16_bf16(PAF(3),VFR(3),o[0],0,0,0), C1,8); \
    GAPB(o[1]=__builtin_amdgcn_mfma_f32_32x32x16_bf16(PAF(3),VFR(7),o[1],0,0,0), C1,12); \
    }while(0)
  int t=1;
  #undef CMASK
  #define CMASK(P0,P1,t) do{}while(0)
  for(;t+5<NT;t+=2){
    STEP(pB0,pB1,pA0,pA1,t,true,true,true);     WAIT_BAR(2); RESC(); ROT();
    STEP(pA0,pA1,pB0,pB1,t+1,true,true,true);   WAIT_BAR(2); RESC(); ROT();
  }
  #undef CMASK
  #define CMASK(P0,P1,t) do{}while(0)
  #define ENDW(tt) do{ if((tt)+3<NT){WAIT_BAR(2);} else if((tt)+2<NT){WAIT_BAR(1);} else {WAIT_BAR(0);} }while(0)
  for(;t+1<NT;t+=2){
    STEP(pB0,pB1,pA0,pA1,t,(t+3<NT),(t+1<NT),(t+1<NT));       ENDW(t);   RESC(); ROT();
    STEP(pA0,pA1,pB0,pB1,t+1,(t+4<NT),(t+2<NT),(t+2<NT));     ENDW(t+1); RESC(); ROT();
  }
  STEP(pB0,pB1,pA0,pA1,NT-1,false,false,false); RESC();
  { float sacc=pB0[0]+pB0[1]; _Pragma("unroll") for(int r=2;r<16;++r)sacc+=pB0[r]; _Pragma("unroll") for(int r=0;r<16;++r)sacc+=pB1[r]; l_reg+=sacc;
    pw0=(u32x4){PKW(pB0,0),PKW(pB0,2),PKW(pB0,4),PKW(pB0,6)};pw1=(u32x4){PKW(pB0,8),PKW(pB0,10),PKW(pB0,12),PKW(pB0,14)};pw2=(u32x4){PKW(pB1,0),PKW(pB1,2),PKW(pB1,4),PKW(pB1,6)};pw3=(u32x4){PKW(pB1,8),PKW(pB1,10),PKW(pB1,12),PKW(pB1,14)};
    SBAR(); pv(o,vb0+sl_cur,PAF(0),PAF(1),PAF(2),PAF(3)); }
  #undef PKW
  #undef PAF
  #undef VFR
  #undef PIN
  #undef MX3
  #undef GAPA
  #undef GAPB
  #undef EX
  #undef VRD
  #undef KRD
  #undef STEP
  #undef ENDW
  {auto rr=__builtin_amdgcn_permlane32_swap(__float_as_uint(l_reg),__float_as_uint(l_reg),false,false);l_reg=__uint_as_float(rr[0])+__uint_as_float(rr[1]);}
  if(hi==0)wsf[32+r32]=l_reg;asm volatile("s_waitcnt lgkmcnt(0)":::"memory");
  float rli[16];
  #pragma unroll
  for(int r=0;r<16;++r)rli[r]=__builtin_amdgcn_rcpf(wsf[32+crow(r,hi)]);
  bf16*Ow=O+(rowbase+q0+wid*QBLK)*OP+OCOL+h*D; float*Sw=SSB+(rowbase+q0+wid*QBLK)*NHEAD+h;
  { bf16*stg=(bf16*)(shm+LDS_OST)+wid*2048;
    #pragma unroll
    for(int r=0;r<16;++r){const int orow=crow(r,hi);
      #pragma unroll
      for(int d0=0;d0<2;++d0)stg[orow*64+d0*32+r32]=__float2bfloat16(o[d0][r]*rli[r]);}
    asm volatile("s_waitcnt lgkmcnt(0)":::"memory");
    #pragma unroll
    for(int i=0;i<4;++i){const int row=i*8+(lane>>3),ch=lane&7; const u32x4 v=*(const u32x4*)(stg+row*64+ch*8); ATTN_STORE16(Ow+(long)row*OP+ch*8,v);
      float ss=0.f;
      #pragma unroll
      for(int j=0;j<4;++j){const float lo=__builtin_bit_cast(float,v[j]<<16),hi2=__builtin_bit_cast(float,v[j]&0xffff0000u); ss+=lo*lo+hi2*hi2;}
      ss+=__shfl_xor(ss,1);ss+=__shfl_xor(ss,2);ss+=__shfl_xor(ss,4); if(ch==0)Sw[(long)row*NHEAD]=ss;} }
  asm volatile("s_waitcnt lgkmcnt(0)\n\ts_barrier":::"memory");
  #undef DMA_K
  #undef DMA_V
  #undef CMASK
  #undef START
  #undef RESC
  #undef ROT
}
constexpr int ATTN_LDS_BYTES=LDS_BYTES;
struct AttnTensors { const bf16* Q; const bf16* K; const bf16* V; bf16* O; float* SSB; };
struct AttnUnit { int bh; int qb; };
struct StaticOrder {
  int vcu,G;
  __device__ __forceinline__ explicit StaticOrder(int grid,int v):vcu(v),G(grid){}
  __device__ __forceinline__ bool next(int i,AttnUnit&u)const{
    if(G==256){ if(i>=4)return false; const int grp=4*(vcu>>5)+i,l=vcu&31; u.bh=(grp>>1)*NHEAD+(grp&1)*4+(l>>3); u.qb=l&7; return true; }
    const long L=(long)i*G+vcu; if(L>=(long)BATCH*NHEAD*NQB)return false; u.bh=(int)(L/NQB); u.qb=(int)(L%NQB); return true; }
};
template<class Sched,int THRL=8> __device__ __forceinline__ void attn_phase(char*lds,const AttnTensors&T,const Sched&S){
  AttnUnit u;
  for(int i=0;S.next(i,u);++i){ attn_unit<THRL>(u.bh/NHEAD,u.bh%NHEAD,u.qb,T.Q,T.K,T.V,T.O,T.SSB,lds); }
}
#undef SBAR
#undef WAIT_BAR
}
#define GAS __attribute__((address_space(1)))
#define LAS __attribute__((address_space(3)))
typedef unsigned v4u __attribute__((ext_vector_type(4)));
typedef float f32x4 __attribute__((ext_vector_type(4)));
typedef short bf16x8 __attribute__((ext_vector_type(8)));
typedef GAS unsigned gu32;
typedef GAS unsigned long long gu64;
#define RLX_AGENT __ATOMIC_RELAXED, __HIP_MEMORY_SCOPE_AGENT
#define LDS_WAIT() asm volatile("s_waitcnt lgkmcnt(0)" ::: "memory")
#define VM_WAIT() asm volatile("s_waitcnt vmcnt(0)" ::: "memory")
__device__ __forceinline__ unsigned long long rt() { return __builtin_amdgcn_s_memrealtime(); }
__device__ __forceinline__ unsigned pk2(float lo, float hi) { return f2bf(lo) | (f2bf(hi) << 16); }

#define XB_TMO      128
#define XB_XCNT(j)  (256  + 64 * (j))
#define XB_XSUB(j)  (1280 + 64 * (j))
#define XB_XGEN(j)  (2304 + 64 * (j))
#define XB_TOP      3328
#define XB_TOPGEN   3392
#define XCD_BAR_WORDS 3456
#define XB_SPIN_CAP (1u << 18)

__device__ __forceinline__ unsigned xb_ld(unsigned* p)              { return __hip_atomic_load(p, __ATOMIC_RELAXED, __HIP_MEMORY_SCOPE_AGENT); }
__device__ __forceinline__ unsigned xb_add(unsigned* p, unsigned v) { return __hip_atomic_fetch_add(p, v, __ATOMIC_RELAXED, __HIP_MEMORY_SCOPE_AGENT); }
__device__ __forceinline__ unsigned xb_xcc_id() { return (unsigned)__builtin_amdgcn_s_getreg((3 << 11) | 20) & 0xFu; }
#define XB_SPIN(cond, bar) do { unsigned _sp = 0; while (cond) { __builtin_amdgcn_s_sleep(1); \
    if ((++_sp & 255u) == 0u) { if (xb_ld(&(bar)[XB_TMO])) break; if (_sp > XB_SPIN_CAP) { atomicAdd(&(bar)[XB_TMO], 1u); break; } } } } while (0)

struct XcdBarrier {
    unsigned* bar; unsigned x;
    volatile LAS unsigned* st;
};

__device__ __forceinline__ XcdBarrier xcd_barrier_post(unsigned* bar, volatile LAS unsigned* st) {
    XcdBarrier b; b.bar = bar; b.x = xb_xcc_id(); b.st = st;
    if (threadIdx.x == 0) (void)xb_add(&bar[XB_XCNT(b.x)], 1u);
    return b;
}
__device__ __forceinline__ void xcd_barrier_complete(unsigned* bar, unsigned x, unsigned& nloc, unsigned& nx) {
    const unsigned G = gridDim.x * gridDim.y * gridDim.z;
    unsigned sum, cnt, mine, sp = 0u;
    for (;;) {
        sum = 0u; cnt = 0u; mine = 0u;
#pragma unroll
        for (unsigned j = 0; j < 16; ++j) { const unsigned c = xb_ld(&bar[XB_XCNT(j)]); sum += c; cnt += (c > 0u) ? 1u : 0u; mine = (j == x) ? c : mine; }
        if (sum == G) break;
        __builtin_amdgcn_s_sleep(1);
        if ((++sp & 255u) == 0u) { if (xb_ld(&bar[XB_TMO])) break; if (sp > XB_SPIN_CAP) { atomicAdd(&bar[XB_TMO], 1u); break; } }
    }
    nloc = mine > 0u ? mine : 1u; nx = cnt > 0u ? cnt : 1u;
}

__device__ __forceinline__ void xcd_barrier(const XcdBarrier& b) {
    asm volatile("s_waitcnt vmcnt(0)" ::: "memory");
    __syncthreads();
    if (threadIdx.x == 0) {
        unsigned* bar = b.bar;
        __builtin_amdgcn_s_waitcnt(0);
        unsigned nloc = b.st[0], nx = b.st[1];
        if (nloc == 0u) { xcd_barrier_complete(bar, b.x, nloc, nx); b.st[0] = nloc; b.st[1] = nx; }
        const unsigned old = xb_add(&bar[XB_XSUB(b.x)], 1u);
        const unsigned gen = old / nloc;
        if (old + 1u == (gen + 1u) * nloc) {
            __builtin_amdgcn_fence(__ATOMIC_RELEASE, "agent");
            asm volatile("s_waitcnt vmcnt(0)" ::: "memory");
            const unsigned og = xb_add(&bar[XB_TOP], 1u);
            const unsigned tg = og / nx;
            if (og + 1u == (tg + 1u) * nx) xb_add(&bar[XB_TOPGEN], 1u);
            else XB_SPIN(xb_ld(&bar[XB_TOPGEN]) == tg, bar);
            __builtin_amdgcn_fence(__ATOMIC_ACQUIRE, "agent");
            xb_add(&bar[XB_XGEN(b.x)], 1u);
            asm volatile("s_waitcnt vmcnt(0)" ::: "memory");
        } else {
            XB_SPIN(xb_ld(&bar[XB_XGEN(b.x)]) == gen, bar);
            __builtin_amdgcn_fence(__ATOMIC_ACQUIRE, "agent");
            asm volatile("s_waitcnt vmcnt(0)" ::: "memory");
        }
    }
    __syncthreads();
}
constexpr int NWAVES = 8;
constexpr int RING_OFF = 0, RING_BYTES = 131072;
constexpr int LDSCTL_OFF = RING_BYTES, MISC_OFF = LDSCTL_OFF + 320;
constexpr int LDS_BYTES = 147456;
constexpr int CW_TMO = 0, CW_CODE = 1, CW_BAR = 4096;
constexpr int N_PHASES = 10;

struct Frame {
    LAS unsigned char* lds;
    volatile LAS unsigned* MISC;
    gu32* ctl;
    int tid, lane, wave, vcu, G;
};
struct Args { const float* in[17]; float* out; unsigned char* ws; int ph_lo, ph_hi, li, pad; };

__device__ __forceinline__ float gelu_fast(float x) {
    const float t = x * (-2.3022082f + -0.10294324f * x * x);
    return x * __builtin_amdgcn_rcpf(1.0f + __builtin_amdgcn_exp2f(t));
}
struct EpiInProj {
    static constexpr bool PERM = true;
    bf16 *U, *VG, *Q, *Kb, *Vb; const float *gv, *gq, *gk, *cosT, *sinT;
    __device__ __forceinline__ void operator()(const pg8::f32x4 (&acc)[2][2][4][2], const pg8::Unit& u, int wr, int wc, int fr, int fq) const {
        using pg8::f32x4; using pg8::u32x4;
        const int pn = u.pn;
        int kind, head;
        if (pn < 2) { kind = 0; head = pn * 4 + wc; } else if (pn < 4) { kind = 1; head = (pn - 2) * 4 + wc; } else if (pn < 6) { kind = 2; head = (pn - 4) * 4 + wc; } else { kind = (wc < 2) ? 3 : 4; head = wc & 1; }
        bf16* outp; int pitch; const float* gp = gq;
        if (kind == 0) { outp = U + head * 64; pitch = AW; } else if (kind == 1) { outp = VG + head * 64; pitch = AW; gp = gv + head * 64; }
        else if (kind == 2) { outp = Q + head * 64; pitch = BW; gp = gq; } else if (kind == 3) { outp = Kb + head * 64; pitch = KVW; gp = gk; } else { outp = Vb + head * 64; pitch = KVW; }
        const int dl = 8 * fq, fi = 8 * (fq & 1);
        f32x4 gg[2][2];
#pragma unroll
        for (int bj = 0; bj < 2; ++bj)
#pragma unroll
            for (int n = 0; n < 2; ++n) gg[bj][n] = (f32x4){1.f, 1.f, 1.f, 1.f};
        if (kind >= 1 && kind <= 3) {
#pragma unroll
            for (int bj = 0; bj < 2; ++bj)
#pragma unroll
                for (int n = 0; n < 2; ++n) gg[bj][n] = *(const f32x4*)(gp + 32 * bj + dl + 4 * n);
            asm volatile("" : "+v"(gg[0][0]), "+v"(gg[0][1]), "+v"(gg[1][0]), "+v"(gg[1][1]));
        }
#pragma unroll
        for (int ai = 0; ai < 2; ++ai)
#pragma unroll
            for (int m = 0; m < 4; ++m) {
                const int row = u.pm * 256 + ai * 128 + wr * 64 + m * 16 + fr;
                f32x4 v[2][2];
#pragma unroll
                for (int bj = 0; bj < 2; ++bj)
#pragma unroll
                    for (int n = 0; n < 2; ++n) v[bj][n] = acc[ai][bj][m][n];
                if (kind <= 1) {
#pragma unroll
                    for (int bj = 0; bj < 2; ++bj)
#pragma unroll
                        for (int n = 0; n < 2; ++n)
#pragma unroll
                            for (int e = 0; e < 4; ++e) v[bj][n][e] = gelu_fast(v[bj][n][e]);
                }
                if (kind >= 1 && kind <= 3) {
                    float ss = 0.f;
#pragma unroll
                    for (int bj = 0; bj < 2; ++bj)
#pragma unroll
                        for (int n = 0; n < 2; ++n)
#pragma unroll
                            for (int e = 0; e < 4; ++e) ss += v[bj][n][e] * v[bj][n][e];
                    ss += __shfl_xor(ss, 16); ss += __shfl_xor(ss, 32);
                    const float rstd = rsqrtf(ss * (1.0f / 64.0f) + EPS);
#pragma unroll
                    for (int bj = 0; bj < 2; ++bj)
#pragma unroll
                        for (int n = 0; n < 2; ++n) v[bj][n] = v[bj][n] * rstd * gg[bj][n];
                }
                if (kind == 2 || kind == 3) {
                    const int t = row & (SEQ - 1);
                    const float sc = (kind == 2) ? QSCALE : 1.0f;
#pragma unroll
                    for (int bj = 0; bj < 2; ++bj) {
                        const int pos = bj ? (t & 63) : (t >> 6);
#pragma unroll
                        for (int n = 0; n < 2; ++n) {
                            const f32x4 c4 = *(const f32x4*)(cosT + pos * 16 + fi + 4 * n), s4 = *(const f32x4*)(sinT + pos * 16 + fi + 4 * n);
#pragma unroll
                            for (int e = 0; e < 4; ++e) {
                                const float me = v[bj][n][e], pa = __shfl_xor(me, 32);
                                const float o = (fq < 2) ? (me * c4[e] - pa * s4[e]) : (me * c4[e] + pa * s4[e]);
                                v[bj][n][e] = o * sc;
                            }
                        }
                    }
                }
#pragma unroll
                for (int bj = 0; bj < 2; ++bj) {
                    u32x4 w; w.x = pg8::cvt_pk_bf16(v[bj][0][0], v[bj][0][1]); w.y = pg8::cvt_pk_bf16(v[bj][0][2], v[bj][0][3]); w.z = pg8::cvt_pk_bf16(v[bj][1][0], v[bj][1][1]); w.w = pg8::cvt_pk_bf16(v[bj][1][2], v[bj][1][3]);
                    *(u32x4*)(outp + (size_t)row * pitch + 32 * bj + dl) = w;
                }
            }
    }
};


struct EpiOutProj {
    static constexpr bool PERM = true;
    const float* x; const float* SSB; float* X1; bf16* X1B;
    __device__ __forceinline__ void operator()(const pg8::f32x4 (&acc)[2][2][4][2], const pg8::Unit& u, int wr, int wc, int fr, int fq) const {
        using pg8::f32x4; using pg8::u32x4;
        const int col0 = u.pn * 256 + wc * 32 + 8 * fq;
#pragma unroll
        for (int ai = 0; ai < 2; ++ai)
#pragma unroll
            for (int m = 0; m < 4; ++m) {
                const size_t row = (size_t)(u.pm * 256 + ai * 128 + wr * 64 + m * 16 + fr);
                const f32x4 s0 = *(const f32x4*)(SSB + row * 8), s1 = *(const f32x4*)(SSB + row * 8 + 4);
                const float rstd_b = rsqrtf(((s0[0] + s0[1]) + (s0[2] + s0[3]) + (s1[0] + s1[1]) + (s1[2] + s1[3])) * (1.0f / BW) + EPS);
#pragma unroll
                for (int bj = 0; bj < 2; ++bj) {
                    const size_t off = row * DM + col0 + bj * 128;
                    const f32x4 x0 = *(const f32x4*)(x + off), x1 = *(const f32x4*)(x + off + 4);
                    const f32x4 o0 = x0 + acc[ai][bj][m][0] * rstd_b, o1 = x1 + acc[ai][bj][m][1] * rstd_b;
                    *(f32x4*)(X1 + off) = o0; *(f32x4*)(X1 + off + 4) = o1;
                    u32x4 w; w.x = pg8::cvt_pk_bf16(o0[0], o0[1]); w.y = pg8::cvt_pk_bf16(o0[2], o0[3]); w.z = pg8::cvt_pk_bf16(o1[0], o1[1]); w.w = pg8::cvt_pk_bf16(o1[2], o1[3]);
                    *(u32x4*)(X1B + off) = w;
                }
            }
    }
};

struct EpiGateUp {
    static constexpr bool PERM = true;
    const int* IDX; const float* RS2; bf16* HH;
    __device__ __forceinline__ void operator()(const pg8::f32x4 (&acc)[2][2][4][2], const pg8::Unit& u, int wr, int wc, int fr, int fq) const {
        using pg8::f32x4; using pg8::u32x4;
        const int col0 = u.pn * 128 + wc * 32 + 8 * fq;
#pragma unroll
        for (int ai = 0; ai < 2; ++ai)
#pragma unroll
            for (int m = 0; m < 4; ++m) {
                const size_t slot = (size_t)(u.pm * 256 + ai * 128 + wr * 64 + m * 16 + fr);
                const float rs = RS2[IDX[slot]];
                float h[8];
#pragma unroll
                for (int n = 0; n < 2; ++n)
#pragma unroll
                    for (int e = 0; e < 4; ++e) { const float a = acc[ai][0][m][n][e] * rs, b = acc[ai][1][m][n][e] * rs;
                        h[4 * n + e] = a * __builtin_amdgcn_rcpf(1.0f + __builtin_amdgcn_exp2f(-1.4426950408889634f * a)) * b; }
                u32x4 w; w.x = pg8::cvt_pk_bf16(h[0], h[1]); w.y = pg8::cvt_pk_bf16(h[2], h[3]); w.z = pg8::cvt_pk_bf16(h[4], h[5]); w.w = pg8::cvt_pk_bf16(h[6], h[7]);
                *(u32x4*)(HH + slot * EFF + col0) = w;
            }
    }
};
struct EpiDown {
    static constexpr bool PERM = true;
    const float* GSEL; bf16* Y;
    __device__ __forceinline__ void operator()(const pg8::f32x4 (&acc)[2][2][4][2], const pg8::Unit& u, int wr, int wc, int fr, int fq) const {
        using pg8::f32x4; using pg8::u32x4;
        const int col0 = u.pn * 256 + wc * 32 + 8 * fq;
#pragma unroll
        for (int ai = 0; ai < 2; ++ai)
#pragma unroll
            for (int m = 0; m < 4; ++m) {
                const size_t slot = (size_t)(u.pm * 256 + ai * 128 + wr * 64 + m * 16 + fr);
                const float g = GSEL[slot];
#pragma unroll
                for (int bj = 0; bj < 2; ++bj) {
                    const f32x4 o0 = acc[ai][bj][m][0] * g, o1 = acc[ai][bj][m][1] * g;
                    u32x4 w; w.x = pg8::cvt_pk_bf16(o0[0], o0[1]); w.y = pg8::cvt_pk_bf16(o0[2], o0[3]); w.z = pg8::cvt_pk_bf16(o1[0], o1[1]); w.w = pg8::cvt_pk_bf16(o1[2], o1[3]);
                    *(u32x4*)(Y + slot * DM + col0 + bj * 128) = w;
                }
            }
    }
};

__device__ __forceinline__ void p0_item(const float* W, int ldw, const float* gs, int k0, int n0, bf16* WT, int Kp, int prow0, LAS float* scr, int lane) {
    float w[32];
    const float* wp = W + (size_t)(k0 + (lane >> 5)) * ldw + n0 + (lane & 31);
#pragma unroll
    for (int i = 0; i < 32; ++i) w[i] = wp[(size_t)(2 * i) * ldw];
    if (gs) {
#pragma unroll
        for (int i = 0; i < 32; ++i) w[i] *= gs[2 * i + (lane >> 5)];
    }
#pragma unroll
    for (int i = 0; i < 32; ++i) scr[(2 * i + (lane >> 5)) * 33 + (lane & 31)] = w[i];
    LDS_WAIT(); asm volatile("" ::: "memory");
    const int c = lane & 7;
#pragma unroll
    for (int j = 0; j < 4; ++j) { const int n = (lane >> 3) + 8 * j; const LAS float* s = scr + (8 * c) * 33 + n;
        v4u o; o.x = pk2(s[0 * 33], s[1 * 33]); o.y = pk2(s[2 * 33], s[3 * 33]); o.z = pk2(s[4 * 33], s[5 * 33]); o.w = pk2(s[6 * 33], s[7 * 33]);
        *(GAS v4u*)(WT + (size_t)(prow0 + n) * Kp + k0 + 8 * c) = o; }
    LDS_WAIT(); asm volatile("" ::: "memory");
}
__device__ __forceinline__ void p0_prologue(Frame& F, const Args& a) {
    unsigned char* ws = a.ws;
    const float* x = a.in[0]; const float* g_mix = a.in[1]; const float* w_in = a.in[2]; const float* g_a = a.in[8]; const float* g_b = a.in[9]; const float* w_out = a.in[10];
    const float* g_ffn = a.in[11]; const float* w_gate = a.in[13]; const float* w_up = a.in[14]; const float* w_down = a.in[15];
    bf16* Win_t = (bf16*)(ws + WS_WIN); bf16* Wout_t = (bf16*)(ws + WS_WOUT); bf16* Wgu_t = (bf16*)(ws + WS_WGU); bf16* Wd_t = (bf16*)(ws + WS_WD); bf16* XN = (bf16*)(ws + WS_XN);
    LAS float* scr = (LAS float*)(F.lds + RING_OFF + F.wave * 16384);
    const int gw = F.vcu * NWAVES + F.wave, NGW = F.G * NWAVES;
    constexpr int I_IN = (DM / 64) * (INW / 32), I_OUT = (DM / 64) * (DM / 32), I_E = (DM / 64) * (EFF / 32), I_EXP = NE * I_E;
    constexpr int NITEMS = I_IN + I_OUT + 3 * I_EXP;
    for (int it = gw; it < NITEMS; it += NGW) {
        int r = it;
        if (r < I_IN) { const int kb = r / (INW / 32), nb = r % (INW / 32), k0 = 64 * kb, L0 = 32 * nb, j = L0 >> 8, Lt = L0 & 255;
            p0_item(w_in, INW, g_mix + k0, k0, L0, Win_t, DM, 256 * j + 128 * ((Lt & 63) >> 5) + 32 * (Lt >> 6), scr, F.lane); continue; }
        r -= I_IN;
        if (r < I_OUT) { const int kb = r / (DM / 32), nb = r % (DM / 32), k0 = 64 * kb;
            p0_item(w_out, DM, (k0 < AW ? g_a + k0 : g_b + (k0 - AW)), k0, 32 * nb, Wout_t, DM, 32 * nb, scr, F.lane); continue; }
        r -= I_OUT;
        if (r < 2 * I_EXP) { const int up = r >= I_EXP; if (up) r -= I_EXP; const int e = r / I_E, q = r % I_E, kb = q / (EFF / 32), nb = q % (EFF / 32), k0 = 64 * kb, n0 = 32 * nb;
            p0_item((up ? w_up : w_gate) + (size_t)e * DM * EFF, EFF, g_ffn + k0, k0, n0, Wgu_t, DM, e * 2048 + 256 * (n0 >> 7) + 128 * up + (n0 & 127), scr, F.lane); continue; }
        r -= 2 * I_EXP;
        { const int e = r / I_E, q = r % I_E, kb = q / (DM / 32), nb = q % (DM / 32), k0 = 64 * kb, n0 = 32 * nb;
            p0_item(w_down + (size_t)e * EFF * DM, DM, nullptr, k0, n0, Wd_t, EFF, e * DM + n0, scr, F.lane); }
    }
    for (int m = gw; m < T; m += 2 * NGW) {
        const int m2 = (m + NGW < T) ? m + NGW : m;
        const GAS f32x4* xa = (const GAS f32x4*)(x + (size_t)m * DM) + F.lane; const GAS f32x4* xb = (const GAS f32x4*)(x + (size_t)m2 * DM) + F.lane;
        f32x4 va[4], vb[4]; float sa = 0.f, sb = 0.f;
#pragma unroll
        for (int j = 0; j < 4; ++j) { va[j] = xa[64 * j]; vb[j] = xb[64 * j]; }
#pragma unroll
        for (int j = 0; j < 4; ++j) { sa += (va[j].x * va[j].x + va[j].y * va[j].y) + (va[j].z * va[j].z + va[j].w * va[j].w); sb += (vb[j].x * vb[j].x + vb[j].y * vb[j].y) + (vb[j].z * vb[j].z + vb[j].w * vb[j].w); }
#pragma unroll
        for (int o = 1; o < 64; o <<= 1) { sa += __shfl_xor(sa, o); sb += __shfl_xor(sb, o); }
        const float ra = rsqrtf(sa * (1.0f / DM) + EPS), rb = rsqrtf(sb * (1.0f / DM) + EPS);
        GAS unsigned long long* oa = (GAS unsigned long long*)(XN + (size_t)m * DM) + F.lane; GAS unsigned long long* ob = (GAS unsigned long long*)(XN + (size_t)m2 * DM) + F.lane;
#pragma unroll
        for (int j = 0; j < 4; ++j) { oa[64 * j] = (unsigned long long)pk2(va[j].x * ra, va[j].y * ra) | ((unsigned long long)pk2(va[j].z * ra, va[j].w * ra) << 32);
                                      ob[64 * j] = (unsigned long long)pk2(vb[j].x * rb, vb[j].y * rb) | ((unsigned long long)pk2(vb[j].z * rb, vb[j].w * rb) << 32); }
    }
    { const float* w_s = a.in[4]; bf16* Wsb = (bf16*)(ws + WS_WS); const int gt0 = (F.vcu * NWAVES + F.wave) * 64 + F.lane;
      for (int i = gt0; i < AH * CHUNK * CHUNK / 4; i += NGW * 64) { const f32x4 w4 = *(const f32x4*)(w_s + 4 * i); *(unsigned long long*)(Wsb + 4 * i) = (unsigned long long)pk2(w4[0], w4[1]) | ((unsigned long long)pk2(w4[2], w4[3]) << 32); } }
    { int* INV = (int*)(ws + WS_INV); const int gt = (F.vcu * NWAVES + F.wave) * 64 + F.lane, NGT = NGW * 64;
      for (int i = gt; i < T * NE / 4; i += NGT) ((GAS v4u*)INV)[i] = (v4u){0xffffffffu, 0xffffffffu, 0xffffffffu, 0xffffffffu};
      if (gt < 64 * 16) { float* cosT = (float*)(ws + WS_ROPE); float* sinT = cosT + 1024; const int pos = gt >> 4, i = gt & 15;
          const float ang = (float)pos * powf(10000.0f, -(float)i / 16.0f); cosT[gt] = cosf(ang); sinT[gt] = sinf(ang); } }
}

template <int M> __device__ __forceinline__ float swz_xor(float v) { return __builtin_bit_cast(float, __builtin_amdgcn_ds_swizzle(__builtin_bit_cast(int, v), 0x1f | (M << 10))); }

constexpr int VTS = 136;
__device__ __forceinline__ void p3_gmlp(Frame& F, const Args& a) {
    unsigned char* ws = a.ws;
    const bf16* U = (const bf16*)(ws + WS_U); const bf16* VG = (const bf16*)(ws + WS_VG); const bf16* Wsb = (const bf16*)(ws + WS_WS); const float* b_s = a.in[5];
    const float* SSB = (const float*)(ws + WS_SSB); bf16* A2 = (bf16*)(ws + WS_A2);
    LAS bf16* vt = (LAS bf16*)(F.lds + RING_OFF);
    const int w = F.wave, l = F.lane, pr = l & 15, dq = l >> 4, tq = F.tid >> 2, tdc = F.tid & 3;
    for (int unit = F.vcu; unit < BATCH * (SEQ / CHUNK); unit += F.G) {
        const size_t row0 = (size_t)unit * CHUNK, row = row0 + 16 * w + pr;
        float av[8][4][4]; float ss = 0.f;
#pragma unroll
        for (int h = 0; h < 8; ++h) {
            __syncthreads();
            { const bf16* src = VG + (row0 + tq) * AW + h * 64 + tdc * 16; const v4u x0 = *(const v4u*)src, x1 = *(const v4u*)(src + 8);
#pragma unroll
              for (int j = 0; j < 4; ++j) { vt[(tdc * 16 + 2 * j) * VTS + tq] = (bf16)(x0[j] & 0xffffu); vt[(tdc * 16 + 2 * j + 1) * VTS + tq] = (bf16)(x0[j] >> 16);
                                            vt[(tdc * 16 + 8 + 2 * j) * VTS + tq] = (bf16)(x1[j] & 0xffffu); vt[(tdc * 16 + 8 + 2 * j + 1) * VTS + tq] = (bf16)(x1[j] >> 16); } }
            __syncthreads();
            bf16x8 bw[4];
#pragma unroll
            for (int ks = 0; ks < 4; ++ks) bw[ks] = *(const bf16x8*)(Wsb + ((size_t)(h * CHUNK + 16 * w + pr) * CHUNK + 32 * ks + 8 * dq));
            const float bias = b_s[h * CHUNK + 16 * w + pr];
#pragma unroll
            for (int mt = 0; mt < 4; ++mt) {
                f32x4 acc = (f32x4){0.f, 0.f, 0.f, 0.f};
#pragma unroll
                for (int ks = 0; ks < 4; ++ks) { const bf16x8 af = *(const LAS bf16x8*)(vt + (16 * mt + pr) * VTS + 32 * ks + 8 * dq); acc = __builtin_amdgcn_mfma_f32_16x16x32_bf16(af, bw[ks], acc, 0, 0, 0); }
                const unsigned long long u4 = *(const unsigned long long*)(U + row * AW + h * 64 + 16 * mt + 4 * dq);
#pragma unroll
                for (int r = 0; r < 4; ++r) { const float uv = __builtin_bit_cast(float, (unsigned)((u4 >> (16 * r)) & 0xffffull) << 16); const float o = uv * (acc[r] + bias); av[h][mt][r] = o; ss += o * o; }
            }
        }
        ss += __shfl_xor(ss, 16); ss += __shfl_xor(ss, 32);
        const f32x4 s0 = *(const f32x4*)(SSB + row * 8), s1 = *(const f32x4*)(SSB + row * 8 + 4);
        const float rstd_b = rsqrtf(((s0[0] + s0[1]) + (s0[2] + s0[3]) + (s1[0] + s1[1]) + (s1[2] + s1[3])) * (1.0f / BW) + EPS);
        const float sc = rsqrtf(ss * (1.0f / AW) + EPS) / rstd_b;
#pragma unroll
        for (int h = 0; h < 8; ++h)
#pragma unroll
            for (int mt = 0; mt < 4; ++mt) {
                const unsigned long long o = (unsigned long long)pk2(av[h][mt][0] * sc, av[h][mt][1] * sc) | ((unsigned long long)pk2(av[h][mt][2] * sc, av[h][mt][3] * sc) << 32);
                *(unsigned long long*)(A2 + row * DM + h * 64 + 16 * mt + 4 * dq) = o;
            }
    }
    __syncthreads();
}
constexpr int WRS = 20;
__device__ __forceinline__ void p5_router(Frame& F, const Args& a) {
    unsigned char* ws = a.ws; const float* X1 = a.out; const float* gf = a.in[11]; const float* wr = a.in[12];
    float* AFF = (float*)(ws + WS_AFF); float* RS2 = (float*)(ws + WS_RS2);
    LAS float* wl = (LAS float*)(F.lds + RING_OFF);
    __syncthreads();
    for (int i = F.tid; i < DM * NE / 4; i += NWAVES * 64) { const int c = i >> 2, q = i & 3; const f32x4 w4 = *(const f32x4*)(wr + 4 * i) * gf[c]; *(LAS f32x4*)(wl + c * WRS + 4 * q) = w4; }
    __syncthreads();
    const int gw = F.vcu * NWAVES + F.wave, NGW = F.G * NWAVES, lane = F.lane;
    for (int grp = gw; grp < T / 4; grp += NGW) {
        const int row0 = grp * 4;
        float acc[64]; float ss[4] = {0.f, 0.f, 0.f, 0.f};
#pragma unroll
        for (int j = 0; j < 64; ++j) acc[j] = 0.f;
#pragma unroll 1
        for (int hf = 0; hf < 4; ++hf) {
            float xv[4][4];
#pragma unroll
            for (int r = 0; r < 4; ++r)
#pragma unroll
                for (int i = 0; i < 4; ++i) xv[r][i] = X1[(size_t)(row0 + r) * DM + (hf * 4 + i) * 64 + lane];
#pragma unroll
            for (int i = 0; i < 4; ++i) {
                const LAS float* wp = wl + ((hf * 4 + i) * 64 + lane) * WRS;
                const f32x4 w0 = *(const LAS f32x4*)(wp), w1 = *(const LAS f32x4*)(wp + 4), w2 = *(const LAS f32x4*)(wp + 8), w3 = *(const LAS f32x4*)(wp + 12);
#pragma unroll
                for (int r = 0; r < 4; ++r) { const float x = xv[r][i]; ss[r] += x * x;
#pragma unroll
                    for (int e = 0; e < 4; ++e) { acc[r * 16 + e] += x * w0[e]; acc[r * 16 + 4 + e] += x * w1[e]; acc[r * 16 + 8 + e] += x * w2[e]; acc[r * 16 + 12 + e] += x * w3[e]; } }
            }
        }
        __builtin_amdgcn_sched_barrier(0);
        float b32[32], c16[16], d8[8], e4[4], f2[2], g1;
        { const bool up = lane & 32;
#pragma unroll
          for (int j = 0; j < 32; ++j) { const float send = up ? acc[j] : acc[32 + j], keep = up ? acc[32 + j] : acc[j]; b32[j] = keep + __shfl_xor(send, 32); } }
        __builtin_amdgcn_sched_barrier(0);
        { const bool up = lane & 16;
#pragma unroll
          for (int j = 0; j < 16; ++j) { const float send = up ? b32[j] : b32[16 + j], keep = up ? b32[16 + j] : b32[j]; c16[j] = keep + swz_xor<16>(send); } }
        { const bool up = lane & 8;
#pragma unroll
          for (int j = 0; j < 8; ++j) { const float send = up ? c16[j] : c16[8 + j], keep = up ? c16[8 + j] : c16[j]; d8[j] = keep + swz_xor<8>(send); } }
        { const bool up = lane & 4;
#pragma unroll
          for (int j = 0; j < 4; ++j) { const float send = up ? d8[j] : d8[4 + j], keep = up ? d8[4 + j] : d8[j]; e4[j] = keep + swz_xor<4>(send); } }
        { const bool up = lane & 2;
#pragma unroll
          for (int j = 0; j < 2; ++j) { const float send = up ? e4[j] : e4[2 + j], keep = up ? e4[2 + j] : e4[j]; f2[j] = keep + swz_xor<2>(send); } }
        { const bool up = lane & 1; const float send = up ? f2[0] : f2[1], keep = up ? f2[1] : f2[0]; g1 = keep + swz_xor<1>(send); }
        __builtin_amdgcn_sched_barrier(0);
        float s2[2], s1;
        { const bool up = lane & 32;
#pragma unroll
          for (int j = 0; j < 2; ++j) { const float send = up ? ss[j] : ss[2 + j], keep = up ? ss[2 + j] : ss[j]; s2[j] = keep + __shfl_xor(send, 32); } }
        { const bool up = lane & 16; const float send = up ? s2[0] : s2[1], keep = up ? s2[1] : s2[0]; s1 = keep + swz_xor<16>(send); }
        s1 += swz_xor<8>(s1); s1 += swz_xor<4>(s1); s1 += swz_xor<2>(s1); s1 += swz_xor<1>(s1);
        const float rstd = rsqrtf(s1 * (1.0f / DM) + EPS);
        const float lg = g1 * rstd;
        float mx = lg; mx = fmaxf(mx, swz_xor<8>(mx)); mx = fmaxf(mx, swz_xor<4>(mx)); mx = fmaxf(mx, swz_xor<2>(mx)); mx = fmaxf(mx, swz_xor<1>(mx));
        const float ex = expf(lg - mx);
        float den = ex; den += swz_xor<8>(den); den += swz_xor<4>(den); den += swz_xor<2>(den); den += swz_xor<1>(den);
        const int row = row0 + (lane >> 4), e = lane & 15, b = row / SEQ, sq = row % SEQ;
        AFF[((size_t)b * NE + e) * SEQ + sq] = ex / den;
        if (e == 0) RS2[row] = rstd;
    }
    __syncthreads();
}
__device__ __forceinline__ void p6_topk(Frame& F, const Args& a) {
    unsigned char* ws = a.ws; const float* AFF = (const float*)(ws + WS_AFF);
    int* IDX = (int*)(ws + WS_IDX); float* GSEL = (float*)(ws + WS_GSEL); int* INV = (int*)(ws + WS_INV);
    const int lane = F.lane;
    if (F.wave != 0) return;
    for (int be = F.vcu; be < BATCH * NE; be += F.G) {
        const int b = be / NE, e = be % NE;
        unsigned v[32];
#pragma unroll
        for (int i = 0; i < 32; ++i) v[i] = __builtin_bit_cast(unsigned, AFF[(size_t)be * SEQ + i * 64 + lane]);
        unsigned thr = 0u;
        for (int bit = 30; bit >= 0; --bit) {
            const unsigned cand = thr | (1u << bit); int c = 0;
#pragma unroll
            for (int i = 0; i < 32; ++i) c += (v[i] >= cand) ? 1 : 0;
#pragma unroll
            for (int o = 1; o < 64; o <<= 1) c += __shfl_xor(c, o);
            if (c >= CAP) thr = cand;
        }
        int cg = 0;
#pragma unroll
        for (int i = 0; i < 32; ++i) cg += (v[i] > thr) ? 1 : 0;
#pragma unroll
        for (int o = 1; o < 64; o <<= 1) cg += __shfl_xor(cg, o);
        const int need = CAP - cg;
        int base = 0, tbase = 0;
        const unsigned long long lt = (1ull << lane) - 1ull;
#pragma unroll
        for (int i = 0; i < 32; ++i) {
            const bool gt = v[i] > thr, eq = v[i] == thr;
            const unsigned long long meq = __ballot(eq);
            const int trank = tbase + __popcll(meq & lt);
            const bool sel = gt || (eq && trank < need);
            const unsigned long long ms = __ballot(sel);
            if (sel) { const int slot = base + __popcll(ms & lt), tok = b * SEQ + i * 64 + lane;
                IDX[be * CAP + slot] = tok; GSEL[be * CAP + slot] = __builtin_bit_cast(float, v[i]); INV[(size_t)tok * NE + e] = slot; }
            base += __popcll(ms); tbase += __popcll(meq);
        }
    }
}
typedef unsigned long long u64_t;
#define P9_ISSUE(m, cmine, b, y, n) do { n = 0; \
    _Pragma("unroll") for (int k_ = 0; k_ < 4; ++k_) { if (m) { const int e_ = __builtin_ctzll(m); m &= m - 1ull; const int c_ = __builtin_amdgcn_readlane(cmine, e_); \
        const bf16* yr_ = Y + ((size_t)((b) * NE + e_) * CAP + c_) * DM + 4 * lane; \
        _Pragma("unroll") for (int j_ = 0; j_ < 4; ++j_) y[k_][j_] = *(const u64_t*)(yr_ + 256 * j_); n = k_ + 1; } } } while (0)
#define P9_ACC(v, y, n) do { \
    _Pragma("unroll") for (int k_ = 0; k_ < 4; ++k_) { if (k_ < n) { \
        _Pragma("unroll") for (int j_ = 0; j_ < 4; ++j_) { const u64_t y4 = y[k_][j_]; \
            v[j_][0] += __builtin_bit_cast(float, (unsigned)(y4 & 0xffffull) << 16); v[j_][1] += __builtin_bit_cast(float, (unsigned)((y4 >> 16) & 0xffffull) << 16); \
            v[j_][2] += __builtin_bit_cast(float, (unsigned)((y4 >> 32) & 0xffffull) << 16); v[j_][3] += __builtin_bit_cast(float, (unsigned)(y4 >> 48) << 16); } } } } while (0)
__device__ __forceinline__ void p9_final(Frame& F, const Args& a, float* OUT) {
    unsigned char* ws = a.ws; const float* X1 = a.out; const bf16* Y = (const bf16*)(ws + WS_Y); const int* INV = (const int*)(ws + WS_INV); const float* gfin = a.in[16];
    const int gw = F.vcu * NWAVES + F.wave, NGW = F.G * NWAVES, lane = F.lane;
    f32x4 gv[4];
#pragma unroll
    for (int j = 0; j < 4; ++j) gv[j] = *(const f32x4*)(gfin + 256 * j + 4 * lane);
    int ca = -1, cb = -1;
    if (gw < T) { const int rb0 = (gw + NGW < T) ? gw + NGW : gw; if (lane < NE) { ca = INV[(size_t)gw * NE + lane]; cb = INV[(size_t)rb0 * NE + lane]; } }
    for (int row = gw; row < T; row += 2 * NGW) {
        const bool two = (row + NGW < T); const int rowb = two ? row + NGW : row;
        f32x4 va[4], vb[4];
#pragma unroll
        for (int j = 0; j < 4; ++j) { va[j] = *(const f32x4*)(X1 + (size_t)row * DM + 256 * j + 4 * lane); vb[j] = *(const f32x4*)(X1 + (size_t)rowb * DM + 256 * j + 4 * lane); }
        u64_t ma = __ballot(ca >= 0), mb = __ballot(cb >= 0);
        const int cca = ca, ccb = cb;
        { const int nr = row + 2 * NGW; if (nr < T) { const int nrb = (nr + NGW < T) ? nr + NGW : nr; if (lane < NE) { ca = INV[(size_t)nr * NE + lane]; cb = INV[(size_t)nrb * NE + lane]; } } }
        u64_t ya[4][4], yb[4][4]; int na, nb;
        P9_ISSUE(ma, cca, row / SEQ, ya, na); P9_ISSUE(mb, ccb, rowb / SEQ, yb, nb);
        P9_ACC(va, ya, na); P9_ACC(vb, yb, nb);
        while (ma) { P9_ISSUE(ma, cca, row / SEQ, ya, na); P9_ACC(va, ya, na); }
        while (mb) { P9_ISSUE(mb, ccb, rowb / SEQ, yb, nb); P9_ACC(vb, yb, nb); }
        float sa = 0.f, sb = 0.f;
#pragma unroll
        for (int j = 0; j < 4; ++j) { sa += (va[j][0] * va[j][0] + va[j][1] * va[j][1]) + (va[j][2] * va[j][2] + va[j][3] * va[j][3]); sb += (vb[j][0] * vb[j][0] + vb[j][1] * vb[j][1]) + (vb[j][2] * vb[j][2] + vb[j][3] * vb[j][3]); }
#pragma unroll
        for (int o = 1; o < 64; o <<= 1) { sa += __shfl_xor(sa, o); sb += __shfl_xor(sb, o); }
        const float ra = rsqrtf(sa * (1.0f / DM) + EPS), rb = rsqrtf(sb * (1.0f / DM) + EPS);
#pragma unroll
        for (int j = 0; j < 4; ++j) *(f32x4*)(OUT + (size_t)row * DM + 256 * j + 4 * lane) = va[j] * ra * gv[j];
        if (two) {
#pragma unroll
            for (int j = 0; j < 4; ++j) *(f32x4*)(OUT + (size_t)rowb * DM + 256 * j + 4 * lane) = vb[j] * rb * gv[j];
        }
    }
}

__device__ __forceinline__ void ph1_inproj(Frame& F, const Args& args) {
    unsigned char* ws = args.ws; float* cosT = (float*)(ws + WS_ROPE); float* sinT = cosT + 1024;
    pg8::Prob<false> g{(bf16*)(ws + WS_XN), (bf16*)(ws + WS_WIN), nullptr, DM, 0}; pg8::StaticOrder S; S.init(T, INW, F.G, (int)blockIdx.x);
    EpiInProj E{(bf16*)(ws + WS_U), (bf16*)(ws + WS_VG), (bf16*)(ws + WS_Q), (bf16*)(ws + WS_K), (bf16*)(ws + WS_V), args.in[3], args.in[6], args.in[7], cosT, sinT};
    pg8::gemm_phase<EpiInProj, pg8::Prob<false>, pg8::StaticOrder, true>(F.lds + RING_OFF, g, S, E);
}
__device__ __forceinline__ void ph2_attn(Frame& F, const Args& args, char* lds) {
    unsigned char* ws = args.ws;
    static_assert(attn_body::ATTN_LDS_BYTES <= RING_BYTES, "attention LDS");
    const attn_body::AttnTensors AT{(const attn_body::bf16*)(ws + WS_Q), (const attn_body::bf16*)(ws + WS_K), (const attn_body::bf16*)(ws + WS_V), (attn_body::bf16*)(ws + WS_A2), (float*)(ws + WS_SSB)};
    const attn_body::StaticOrder S((int)F.G, F.vcu);
    attn_body::attn_phase<attn_body::StaticOrder>(lds + RING_OFF, AT, S);
}
__device__ __forceinline__ void ph4_outproj(Frame& F, const Args& args) {
    unsigned char* ws = args.ws;
    pg8::Prob<false> g{(bf16*)(ws + WS_A2), (bf16*)(ws + WS_WOUT), nullptr, DM, 0}; pg8::StaticOrder S; S.init(T, DM, F.G, (int)blockIdx.x);
    EpiOutProj E{args.in[0], (float*)(ws + WS_SSB), args.out, (bf16*)(ws + WS_X1B)};
    pg8::gemm_phase<EpiOutProj, pg8::Prob<false>, pg8::StaticOrder, true>(F.lds + RING_OFF, g, S, E);
}
__device__ __forceinline__ void ph7_gateup(Frame& F, const Args& args) {
    unsigned char* ws = args.ws; int* IDX = (int*)(ws + WS_IDX);
    pg8::Prob<true> g{(bf16*)(ws + WS_X1B), (bf16*)(ws + WS_WGU), IDX, DM, (size_t)2048 * DM}; pg8::MoeOrder S{F.vcu, F.G, 8};
    EpiGateUp E{IDX, (float*)(ws + WS_RS2), (bf16*)(ws + WS_HH)};
    pg8::gemm_phase<EpiGateUp, pg8::Prob<true>, pg8::MoeOrder, true>(F.lds + RING_OFF, g, S, E);
}
__device__ __forceinline__ void ph8_down(Frame& F, const Args& args) {
    unsigned char* ws = args.ws;
    pg8::Prob<false> g{(bf16*)(ws + WS_HH), (bf16*)(ws + WS_WD), nullptr, EFF, (size_t)DM * EFF}; pg8::MoeOrder S{F.vcu, F.G, 4};
    EpiDown E{(float*)(ws + WS_GSEL), (bf16*)(ws + WS_Y)};
    pg8::gemm_phase<EpiDown, pg8::Prob<false>, pg8::MoeOrder, true>(F.lds + RING_OFF, g, S, E);
}

__global__ void __launch_bounds__(NWAVES * 64, 2) mk_fwd(Args args) {
    extern __shared__ __attribute__((aligned(16))) unsigned char lds[];
    Frame F;
    F.lds = (LAS unsigned char*)lds;
    F.MISC = (volatile LAS unsigned*)(F.lds + MISC_OFF);
    F.tid = threadIdx.x; F.lane = F.tid & 63; F.wave = __builtin_amdgcn_readfirstlane(F.tid >> 6);
    F.G = gridDim.x; { const int bx = blockIdx.x; F.vcu = (F.G % 8 == 0) ? (bx % 8) * (F.G / 8) + bx / 8 : bx; }
    unsigned char* ws = args.ws;
    F.ctl = (gu32*)(ws + WS_CTL);
    for (int u = F.tid; u < (LDS_BYTES - LDSCTL_OFF) / 4; u += NWAVES * 64) ((LAS unsigned*)(F.lds + LDSCTL_OFF))[u] = 0u;
    __syncthreads();
    const int lo = args.ph_lo, hi = args.ph_hi;
    XcdBarrier bar; bar.bar = (unsigned*)(F.ctl + CW_BAR) + args.li * XCD_BAR_WORDS; bar.x = 0; bar.st = nullptr;
    if (hi - lo > 1) bar = xcd_barrier_post((unsigned*)(F.ctl + CW_BAR) + args.li * XCD_BAR_WORDS, F.MISC + 8);
#ifndef DBL
#define DBL 0
#endif
#define IN(k) (lo <= (k) && (k) < hi)
#ifndef DBLBAR
#define DBLBAR 0
#endif
#define SEAM(k) do { if (IN(k) && IN((k) + 1)) { xcd_barrier(bar); if (DBLBAR) xcd_barrier(bar); } } while (0)

#define RUN(k, call) do { if (IN(k)) { call; if ((DBL >> (k)) & 1) { call; } if ((k) < N_PHASES - 1) SEAM(k); } } while (0)
    RUN(0, p0_prologue(F, args));
    RUN(1, ph1_inproj(F, args));
    RUN(2, ph2_attn(F, args, (char*)lds));
    RUN(3, p3_gmlp(F, args));
    RUN(4, ph4_outproj(F, args));
    RUN(5, p5_router(F, args));
    RUN(6, p6_topk(F, args));
    RUN(7, ph7_gateup(F, args));
    RUN(8, ph8_down(F, args));
    if (IN(9)) { if ((DBL >> 9) & 1) p9_final(F, args, (float*)(ws + WS_WGU)); p9_final(F, args, args.out); }
#undef RUN
#undef IN
#undef SEAM
}
static int g_grid = 0;
static void launch_mk(const Args& base, int lo, int hi, int li, hipStream_t stream) {
    Args a = base; a.ph_lo = lo; a.ph_hi = hi; a.li = li; a.pad = 0;
    void* params[] = {(void*)&a};
    hipError_t e = hipLaunchCooperativeKernel((const void*)mk_fwd, dim3(g_grid), dim3(NWAVES * 64), params, LDS_BYTES, stream);
    if (e != hipSuccess) fprintf(stderr, "kernel_launch: cooperative launch failed: %s (grid %d)\n", hipGetErrorString(e), g_grid);
}
extern "C" void kernel_launch(void* const* d_in, const int* in_sizes, int n_in, void* d_out, int out_size, void* d_ws, size_t ws_size, hipStream_t stream) {
    if (n_in != 17 || in_sizes[0] != T * DM || out_size != T * DM || ws_size < WS_END) { fprintf(stderr, "kernel_launch: unexpected shapes / workspace (%d inputs, ws %zu)\n", n_in, ws_size); return; }
    if (g_grid == 0) {
        int dev = 0, cus = 0, per_cu = 0;
        if (hipGetDevice(&dev) != hipSuccess || hipDeviceGetAttribute(&cus, hipDeviceAttributeMultiprocessorCount, dev) != hipSuccess) { g_grid = -1; return; }
        if (hipFuncSetAttribute((const void*)mk_fwd, hipFuncAttributeMaxDynamicSharedMemorySize, LDS_BYTES) != hipSuccess) { fprintf(stderr, "kernel_launch: hipFuncSetAttribute failed\n"); g_grid = -1; return; }
        if (hipOccupancyMaxActiveBlocksPerMultiprocessor(&per_cu, (const void*)mk_fwd, NWAVES * 64, LDS_BYTES) != hipSuccess || per_cu < 1) { fprintf(stderr, "kernel_launch: occupancy query says %d blocks per CU\n", per_cu); per_cu = 1; }
        (void)hipGetLastError();
        if (per_cu > 1) per_cu = 1;
        g_grid = cus * per_cu;
    }
    if (g_grid < 0) return;
    unsigned char* ws = (unsigned char*)d_ws; float* out = (float*)d_out;

    (void)hipMemsetAsync((char*)d_ws + WS_CTL, 0, 1 * MiB, stream);
    Args a{};
    for (int i = 0; i < 17; ++i) a.in[i] = (const float*)d_in[i];
    a.out = out; a.ws = ws;
    launch_mk(a, 0, N_PHASES, 0, stream);
}
```
